# Optimizing an MI355X kernel written in HIP

```python
import math
import jax, jax.numpy as jnp
from jax import lax
import numpy as np

D_MODEL = 2048
BATCH = 2
SEQ = 8192
DEPTH = 2

MEM_LEN = 256
N_EVEN = (DEPTH + 1) // 2
N_ODD = DEPTH // 2
WIDTH_A = D_MODEL // 2
WIDTH_B = D_MODEL // 2
POOL_WINDOWS = (2, 4, 8, 16)
N_POOL_GROUPS = len(POOL_WINDOWS)
POOL_GROUP = WIDTH_A // N_POOL_GROUPS
HGRN_HEAD_DIM = 128
HGRN_HEADS = WIDTH_B // HGRN_HEAD_DIM
HGRN_CHUNK = 32
SB_HEAD_DIM = 128
SB_HEADS = D_MODEL // SB_HEAD_DIM
SB_BLOCK = 128
XA_HEADS = 4
XA_HEAD_DIM = D_MODEL // XA_HEADS
EVEN_IN = 2 * WIDTH_A + 4 * WIDTH_B
ODD_IN = 4 * D_MODEL
EPS = 1e-6

kernel_name = 'hybrid_pool_hgrn2_stickbreak_block'


def rms_norm(x, g):
    xf = x.astype(jnp.float32)
    y = xf * lax.rsqrt(jnp.mean(xf * xf, axis=-1, keepdims=True) + EPS)
    return (y * g.astype(jnp.float32)).astype(x.dtype)


def pool_mixer(u, w, scale):
    B, S, _ = u.shape
    ug = u.astype(jnp.float32).reshape(B, S, N_POOL_GROUPS, POOL_GROUP)
    cs = jnp.cumsum(ug, axis=1)
    pooled = []
    for gi, win in enumerate(POOL_WINDOWS):
        c = cs[:, :, gi]
        shifted = jnp.pad(c, ((0, 0), (win, 0), (0, 0)))[:, :S]
        cnt = jnp.minimum(jnp.arange(1, S + 1), win).astype(jnp.float32)
        pooled.append((c - shifted) / cnt[None, :, None])
    mixed = jnp.stack(pooled, axis=2) - ug
    y = jnp.einsum('bsgc,gcd->bsgd', mixed, w.astype(jnp.float32))
    y = y.reshape(B, S, WIDTH_A) * scale.astype(jnp.float32)
    return y.astype(u.dtype)


def hgrn2(q, f_logit, inp, lb, norm_g):
    B, S, _ = q.shape
    H, D, C = HGRN_HEADS, HGRN_HEAD_DIM, HGRN_CHUNK
    N = S // C
    f32 = jnp.float32
    f = lb + (1.0 - lb) * jax.nn.sigmoid(f_logit.astype(f32))
    logf = jnp.log(f)
    k = 1.0 - f

    def heads(t):
        return t.astype(f32).reshape(B, N, C, H, D).transpose(0, 3, 1, 2, 4)

    qh, kh, ih, lfh = heads(q), heads(k), heads(inp), heads(logf)
    bcum = jnp.cumsum(lfh, axis=3)
    q_t = qh * jnp.exp(bcum)
    k_t = kh * jnp.exp(-bcum)
    causal = jnp.tril(jnp.ones((C, C), dtype=bool))
    scores = jnp.where(causal, jnp.einsum('bhncd,bhnsd->bhncs', q_t, k_t), 0.0)
    o_intra = jnp.einsum('bhncs,bhnsv->bhncv', scores, ih)
    b_last = bcum[:, :, :, -1]
    k_end = kh * jnp.exp(b_last[:, :, :, None, :] - bcum)
    U = jnp.einsum('bhnsd,bhnsv->bhndv', k_end, ih)
    decay = jnp.exp(b_last)

    def step(state, xs):
        d, u = xs
        return d[..., None] * state + u, state

    s0 = jnp.zeros((B, H, D, D), f32)
    _, s_prev = lax.scan(step, s0, (decay.transpose(2, 0, 1, 3), U.transpose(2, 0, 1, 3, 4)))
    s_prev = s_prev.transpose(1, 2, 0, 3, 4)
    o = o_intra + jnp.einsum('bhncd,bhndv->bhncv', q_t, s_prev)
    o = o.transpose(0, 2, 3, 1, 4).reshape(B, S, H, D)
    o = o * lax.rsqrt(jnp.mean(o * o, axis=-1, keepdims=True) + EPS)
    o = o * norm_g.astype(f32).reshape(H, D)
    return o.reshape(B, S, WIDTH_B).astype(q.dtype)


def stick_breaking_attention(q, k, v):
    S = q.shape[2]
    scale = 1.0 / math.sqrt(SB_HEAD_DIM)
    outs = []
    for blk in range(S // SB_BLOCK):
        t0, t1 = blk * SB_BLOCK, (blk + 1) * SB_BLOCK
        qb, kb, vb = q[:, :, t0:t1], k[:, :, :t1], v[:, :, :t1]
        z = jnp.einsum('bhtd,bhsd->bhts', qb, kb).astype(jnp.float32) * scale
        mask = jnp.arange(t1)[None, :] < jnp.arange(t0, t1)[:, None]
        log_beta = jax.nn.log_sigmoid(z)
        log_keep = jnp.where(mask, jax.nn.log_sigmoid(-z), 0.0)
        rev = jnp.cumsum(log_keep[..., ::-1], axis=-1)[..., ::-1] - log_keep
        A = jnp.where(mask, jnp.exp(log_beta + rev), 0.0)
        outs.append(jnp.einsum('bhts,bhsd->bhtd', A.astype(vb.dtype), vb))
    return jnp.concatenate(outs, axis=2)


def cross_attention(h, m, wq, wkv, wo):
    B, S, _ = h.shape
    M = m.shape[1]
    q = (h @ wq).reshape(B, S, XA_HEADS, XA_HEAD_DIM)
    k, v = jnp.split(m @ wkv, 2, axis=-1)
    k = k.reshape(B, M, XA_HEADS, XA_HEAD_DIM)
    v = v.reshape(B, M, XA_HEADS, XA_HEAD_DIM)
    s = jnp.einsum('bshd,bmhd->bhsm', q, k).astype(jnp.float32) / math.sqrt(XA_HEAD_DIM)
    p = jax.nn.softmax(s, axis=-1).astype(v.dtype)
    o = jnp.einsum('bhsm,bmhd->bshd', p, v).reshape(B, S, D_MODEL)
    return o @ wo


def setup_inputs(seed: int = 0) -> dict:
    key = jax.random.key(seed)
    ks = jax.random.split(key, 20)
    f32 = jnp.float32
    nrm = lambda k, shape, s: jax.random.normal(k, shape, f32) * s
    return {
        'x': nrm(ks[0], (BATCH, SEQ, D_MODEL), 1.0),
        'mem': nrm(ks[1], (BATCH, MEM_LEN, D_MODEL), 1.0),
        'norm_mix_g': 1.0 + nrm(ks[2], (DEPTH, D_MODEL), 0.02),
        'norm_xa_g': 1.0 + nrm(ks[3], (DEPTH, D_MODEL), 0.02),
        'norm_mem_g': 1.0 + nrm(ks[4], (DEPTH, D_MODEL), 0.02),
        'final_norm_g': 1.0 + nrm(ks[5], (D_MODEL,), 0.02),
        'w_in_even': nrm(ks[6], (N_EVEN, D_MODEL, EVEN_IN), D_MODEL ** -0.5),
        'pool_w': nrm(ks[7], (N_EVEN, N_POOL_GROUPS, POOL_GROUP, POOL_GROUP), POOL_GROUP ** -0.5),
        'pool_scale': 1.0 + nrm(ks[8], (N_EVEN, WIDTH_A), 0.02),
        'hgrn_lower_bounds': nrm(ks[9], (N_EVEN + 1, WIDTH_B), 0.1),
        'hgrn_norm_g': 1.0 + nrm(ks[10], (N_EVEN, WIDTH_B), 0.02),
        'w_out_even': nrm(ks[11], (N_EVEN, WIDTH_A + WIDTH_B, D_MODEL), (WIDTH_A + WIDTH_B) ** -0.5),
        'w_in_odd': nrm(ks[12], (N_ODD, D_MODEL, ODD_IN), D_MODEL ** -0.5),
        'w_out_odd': nrm(ks[13], (N_ODD, D_MODEL, D_MODEL), D_MODEL ** -0.5),
        'xa_wq': nrm(ks[14], (DEPTH, D_MODEL, D_MODEL), D_MODEL ** -0.5),
        'xa_wkv': nrm(ks[15], (DEPTH, D_MODEL, 2 * D_MODEL), D_MODEL ** -0.5),
        'xa_wo': nrm(ks[16], (DEPTH, D_MODEL, D_MODEL), D_MODEL ** -0.5),
    }


def reference(x, mem, norm_mix_g, norm_xa_g, norm_mem_g, final_norm_g,
              w_in_even, pool_w, pool_scale, hgrn_lower_bounds, hgrn_norm_g, w_out_even,
              w_in_odd, w_out_odd, xa_wq, xa_wkv, xa_wo):
    B, S, _ = x.shape
    lb_table = jnp.cumsum(jax.nn.softmax(hgrn_lower_bounds.astype(jnp.float32), axis=0), axis=0)
    for l in range(DEPTH):
        h = rms_norm(x, norm_mix_g[l])
        if l % 2 == 0:
            e = l // 2
            u = h @ w_in_even[e]
            a_in, a_gate, b_q, b_f, b_i, b_gate = jnp.split(u, 6, axis=-1)
            y_a = pool_mixer(a_in, pool_w[e], pool_scale[e]) * jax.nn.silu(a_gate)
            y_b = hgrn2(b_q, b_f, b_i, lb_table[e], hgrn_norm_g[e]) * jax.nn.silu(b_gate)
            x = x + jnp.concatenate([y_a, y_b], axis=-1) @ w_out_even[e]
        else:
            o = l // 2
            u = h @ w_in_odd[o]
            q, k, v, gate = jnp.split(u, 4, axis=-1)
            sh = lambda t: t.reshape(B, S, SB_HEADS, SB_HEAD_DIM).transpose(0, 2, 1, 3)
            att = stick_breaking_attention(sh(q), sh(k), sh(v))
            att = att.transpose(0, 2, 1, 3).reshape(B, S, D_MODEL)
            x = x + (att * jax.nn.silu(gate)) @ w_out_odd[o]
        hx = rms_norm(x, norm_xa_g[l])
        hm = rms_norm(mem, norm_mem_g[l])
        x = x + cross_attention(hx, hm, xa_wq[l], xa_wkv[l], xa_wo[l])
    return rms_norm(x, final_norm_g)
```

```cpp
#include <hip/hip_runtime.h>
#include <hip/hip_cooperative_groups.h>
#include <cstdio>
namespace cg = cooperative_groups;

#define DI __device__ __forceinline__
#define LAS __attribute__((address_space(3)))
typedef unsigned short bf16_t;
typedef short bf16x8 __attribute__((ext_vector_type(8)));
typedef short s16x4 __attribute__((ext_vector_type(4)));
typedef float f32x4 __attribute__((ext_vector_type(4)));
typedef unsigned u32x4 __attribute__((ext_vector_type(4)));
typedef unsigned u32x2 __attribute__((ext_vector_type(2)));

constexpr int DM = 2048, SEQ = 8192, NBATCH = 2, MT = NBATCH * SEQ, MEMLEN = 256;
constexpr int NTH = 512, LDS_BYTES = 147456, LDS_BARST = 147440;
#ifndef PROBE_MASK
#define PROBE_MASK 0u
#endif
constexpr float EPS = 1e-6f;
constexpr int LDU_E = 6144, LDU_O = 8192;

constexpr size_t MiB = 1u << 20;
constexpr size_t WS_WINE = 1 * MiB, WS_WOUTE = 25 * MiB, WS_WINO = 33 * MiB, WS_WOUTO = 65 * MiB, WS_WQ = 73 * MiB, WS_WKV = 89 * MiB, WS_WO = 121 * MiB, WS_POOLT = 137 * MiB;
constexpr size_t WS_HM = 138 * MiB, WS_KX = 142 * MiB, WS_VT = 146 * MiB, WS_XN = 150 * MiB, WS_U = 214 * MiB;
constexpr size_t WS_MIX = 406 * MiB;
constexpr size_t WS_SE = 470 * MiB;
constexpr size_t WS_DT = 502 * MiB;
constexpr size_t WS_DEC = 503 * MiB;
constexpr size_t WS_SS = 502 * MiB + 512 * 1024;
constexpr size_t WS_END = 512 * MiB;

struct Params {
    const float *x, *mem, *g_mix, *g_xa, *g_mem, *g_fin, *w_in_e, *pool_w, *pool_s, *lb, *hg, *w_out_e, *w_in_o, *w_out_o, *wq, *wkv, *wo;
    float* out; unsigned char* ws; int nph, pad;
};

DI unsigned f2bf(float f) { unsigned u = __builtin_bit_cast(unsigned, f); return (u + 0x7fffu + ((u >> 16) & 1u)) >> 16; }
typedef __bf16 bf16x2_t __attribute__((ext_vector_type(2)));
typedef float f32x2_t __attribute__((ext_vector_type(2)));
DI unsigned pk2(float lo, float hi) { f32x2_t f = {lo, hi}; bf16x2_t v = __builtin_convertvector(f, bf16x2_t); return __builtin_bit_cast(unsigned, v); }
DI float bf2f(unsigned v) { return __builtin_bit_cast(float, v << 16); }
DI float bflo(unsigned w) { return __builtin_bit_cast(float, w << 16); }
DI float bfhi(unsigned w) { return __builtin_bit_cast(float, w & 0xffff0000u); }
DI float wave_sum(float v) {
#pragma unroll
    for (int o = 1; o < 64; o <<= 1) v += __shfl_xor(v, o);
    return v;
}
DI int opq_tid() { int t = threadIdx.x; asm volatile("" : "+v"(t)); return t; }
DI int opq_bid() { int b = blockIdx.x; asm volatile("" : "+s"(b)); return b; }
DI float silu(float v) { return v / (1.f + __expf(-v)); }
DI f32x4 mfma16(bf16x8 a, bf16x8 b, f32x4 c) { return __builtin_amdgcn_mfma_f32_16x16x32_bf16(a, b, c, 0, 0, 0); }
DI bf16x8 cat4(s16x4 lo, s16x4 hi) { return __builtin_shufflevector(lo, hi, 0, 1, 2, 3, 4, 5, 6, 7); }

namespace pg8 {
constexpr int BM = 256, BK = 64, HALF = 128, HTB = HALF * BK * 2, STAGE_BYTES = 8 * HTB, NXCD = 8, WGM = 8;
DI int lds_byte(int r, int c) { const int st = (r >> 4) * 2 + (c >> 5), rr = r & 15, cc = c & 31, ob = rr * 64 + cc * 2; return st * 1024 + (ob ^ (((ob >> 9) & 1) << 5)); }
DI void stage_rc(int b, int& R, int& C) { const int st = b / 1024, sb = b % 1024, swz = sb ^ (((sb >> 9) & 1) << 5); R = (st >> 1) * 16 + swz / 64; C = (st & 1) * 32 + (swz % 64) / 2; }
DI int perm32(int rho) { const int n = rho >> 4, i = rho & 15; return 8 * (i >> 2) + 4 * n + (i & 3); }
DI unsigned cvt_pk_bf16(float lo, float hi) { unsigned r; asm volatile("v_cvt_pk_bf16_f32 %0, %1, %2" : "=v"(r) : "v"(lo), "v"(hi)); return r; }

struct Unit { int pm, pn, gi; };
struct Sched {
    const bf16_t* A; const bf16_t* Bt; int lda, ldb, a_pn_bytes, K; long b_batch_stride;
    int nM, nN, nwg, G, c;
    int n_extra; const bf16_t* A2; const bf16_t* B2;
    int pre; const bf16_t* KXl; const bf16_t* VXl; const bf16_t* WQp; const bf16_t* WOt;
    DI void init(const bf16_t* A_, const bf16_t* Bt_, int M, int N, int K_, int lda_, int ldb_, int a_pn_bytes_) {
        A = A_; Bt = Bt_; lda = lda_; ldb = ldb_; a_pn_bytes = a_pn_bytes_; K = K_; b_batch_stride = 0; nM = M / BM; nN = N / BM; nwg = nM * nN; G = gridDim.x; c = opq_bid(); n_extra = 0; A2 = nullptr; B2 = nullptr;
        pre = 0; KXl = nullptr; VXl = nullptr; WQp = nullptr; WOt = nullptr;
    }
    DI bool next(int i, Unit& u) const {
        const long L = (long)i * G + c;
        const long total = pre ? 256 : (long)(nwg + n_extra);
        if (L >= total) return false;
        const bool ex = (!pre) && (L >= nwg); const int e = (int)(L - nwg), Li = (int)L;
        int wgid = (ex || pre) ? 0 : Li; { const int q = nwg / NXCD, r = nwg % NXCD, xcd = wgid % NXCD, off = wgid / NXCD; wgid = (xcd < r ? xcd * (q + 1) : r * (q + 1) + (xcd - r) * q) + off; }
        const int nig = WGM * nN, gid = wgid / nig, fm = gid * WGM, gsz = (nM - fm) < WGM ? (nM - fm) : WGM;
        const int pm0 = fm + ((wgid % nig) % gsz), pn0 = (wgid % nig) / gsz;
        u.pm = pre ? (Li & 7) : (ex ? ((e & 31) >> 4) : pm0);
        u.pn = pre ? ((Li >> 3) & 7) : (ex ? (e & 15) : pn0);
        u.gi = pre ? 3 + ((Li >> 6) & 1) + 2 * (Li >> 7) : (ex ? 1 + (e >> 5) : 0);
        return true;
    }
    DI const char* pa(const Unit& u) const {
        const int b = u.pn >> 2, h = u.pn & 3; const bf16_t* p;
        if (u.gi == 0) p = A + (size_t)u.pm * BM * (size_t)lda + (size_t)u.pn * (a_pn_bytes >> 1);
        else if (u.gi <= 2) p = A2 + ((size_t)(u.gi - 1) * 512 + (size_t)u.pm * BM) * (size_t)lda;
        else if (((u.gi - 3) & 1) == 0) p = KXl + (size_t)((u.gi - 3) >> 1) * 512 * DM + (size_t)(b * 256) * DM + h * 512;
        else p = WOt + (size_t)((u.gi - 3) >> 1) * DM * DM + (size_t)(u.pm * 256) * DM + h * 512;
        return (const char*)p;
    }
    DI const char* pb(const Unit& u) const {
        const int b = u.pn >> 2, h = u.pn & 3; const bf16_t* p;
        if (u.gi == 0) p = Bt + (size_t)(u.pm >> 5) * (size_t)b_batch_stride + (size_t)u.pn * BM * (size_t)ldb;
        else if (u.gi <= 2) p = B2 + ((size_t)(u.gi - 1) * 4096 + (size_t)u.pn * BM) * (size_t)ldb;
        else if (((u.gi - 3) & 1) == 0) p = WQp + (size_t)((u.gi - 3) >> 1) * DM * DM + (size_t)(u.pm * 256) * DM + h * 512;
        else p = VXl + (size_t)((u.gi - 3) >> 1) * 512 * DM + (size_t)(b * 256) * DM + h * 512;
        return (const char*)p;
    }
};

struct Epi {
    int MODE; bool PERM;
    bf16_t* O; int ldc;
    bf16_t* KX; bf16_t* VX;
    bf16_t* BtS1; bf16_t* BtN1; bf16_t* BtS; bf16_t* BtN;
    int vt_lo; bf16_t* VTS0; bf16_t* VTS1;
    const float* res; const bf16_t* resb; float* out; bf16_t* xr_out; float* ss_out;
    const float* ss_in;
    const bf16_t* gate; const float* pscale;
    DI void operator()(const f32x4 (&acc)[2][2][4][2], const Unit& u, int wr, int wc, int fr, int fq) const {
        if (MODE == 1) {
            const int row0 = u.pm * BM + wr * 64 + fr, col0 = u.pn * BM + wc * 32 + 8 * fq;
#pragma unroll
            for (int ai = 0; ai < 2; ++ai) {
                f32x4 rr[4][2][2];
                if (resb) {
                    u32x4 rb[4][2];
#pragma unroll
                    for (int m = 0; m < 4; ++m)
#pragma unroll
                        for (int bj = 0; bj < 2; ++bj) rb[m][bj] = *(const u32x4*)(resb + (size_t)(row0 + ai * HALF + m * 16) * DM + col0 + bj * HALF);
#pragma unroll
                    for (int m = 0; m < 4; ++m)
#pragma unroll
                        for (int bj = 0; bj < 2; ++bj) { rr[m][bj][0] = (f32x4){bflo(rb[m][bj].x), bfhi(rb[m][bj].x), bflo(rb[m][bj].y), bfhi(rb[m][bj].y)};
                            rr[m][bj][1] = (f32x4){bflo(rb[m][bj].z), bfhi(rb[m][bj].z), bflo(rb[m][bj].w), bfhi(rb[m][bj].w)}; }
                } else {
#pragma unroll
                    for (int m = 0; m < 4; ++m)
#pragma unroll
                        for (int bj = 0; bj < 2; ++bj)
#pragma unroll
                            for (int n = 0; n < 2; ++n) rr[m][bj][n] = *(const f32x4*)(res + (size_t)(row0 + ai * HALF + m * 16) * DM + col0 + bj * HALF + 4 * n);
                }
#pragma unroll
                for (int m = 0; m < 4; ++m) { const int row = row0 + ai * HALF + m * 16; const size_t ro = (size_t)row * DM + col0; float ssq = 0.f;
#pragma unroll
                    for (int bj = 0; bj < 2; ++bj) { const f32x4 v0 = acc[ai][bj][m][0] + rr[m][bj][0], v1 = acc[ai][bj][m][1] + rr[m][bj][1];
                        if (xr_out) { u32x4 w; w.x = pk2(v0[0], v0[1]); w.y = pk2(v0[2], v0[3]); w.z = pk2(v1[0], v1[1]); w.w = pk2(v1[2], v1[3]); *(u32x4*)(xr_out + ro + bj * HALF) = w; }
                        else { *(f32x4*)(out + ro + bj * HALF) = v0; *(f32x4*)(out + ro + bj * HALF + 4) = v1; }
                        ssq += ((v0[0] * v0[0] + v0[1] * v0[1]) + (v0[2] * v0[2] + v0[3] * v0[3])) + ((v1[0] * v1[0] + v1[1] * v1[1]) + (v1[2] * v1[2] + v1[3] * v1[3])); }
                    if (ss_out) { ssq += __shfl_xor(ssq, 16); ssq += __shfl_xor(ssq, 32); if (fq == 0) atomicAdd(ss_out + row, ssq); } }
            }
        } else if (MODE == 0) {
            const int row0 = u.pm * BM + wr * 64 + fr;
            const bool sbv = (u.gi == 0) && ((unsigned)(u.pn - vt_lo) < 8u);
            if (!sbv) {
                const int bb = u.pn >> 2, hh = u.pn & 3;
                bf16_t* base; int ld, rowb, colb;
                if (u.gi == 0) { base = O; ld = ldc; rowb = u.pm * BM; colb = u.pn * BM; }
                else if (u.gi <= 2) { base = ((u.pn >= 8) ? VX : KX) + (size_t)(u.gi - 1) * 512 * DM; ld = DM; rowb = u.pm * BM; colb = (u.pn & 7) * BM; }
                else if (((u.gi - 3) & 1) == 0) { base = ((u.gi >= 5) ? BtS1 : BtS) + (size_t)(bb * 1024 + hh * 256) * DM; ld = DM; rowb = 0; colb = u.pm * BM; }
                else { base = ((u.gi >= 5) ? BtN1 : BtN) + (size_t)(bb * 2048 + u.pm * 256) * 1024; ld = 1024; rowb = 0; colb = hh * 256; }
                const int rloc = wr * 64 + fr, col0 = colb + wc * 32 + 8 * fq;
#pragma unroll
                for (int ai = 0; ai < 2; ++ai)
#pragma unroll
                    for (int m = 0; m < 4; ++m) { bf16_t* rowp = base + (size_t)(rowb + rloc + ai * HALF + m * 16) * ld + col0;
                        const float rs_ = ss_in ? rsqrtf(ss_in[row0 + ai * HALF + m * 16] * (1.f / DM) + EPS) : 1.f;
#pragma unroll
                        for (int bj = 0; bj < 2; ++bj) { const f32x4 v0 = acc[ai][bj][m][0] * rs_, v1 = acc[ai][bj][m][1] * rs_;
                            u32x4 w; w.x = cvt_pk_bf16(v0[0], v0[1]); w.y = cvt_pk_bf16(v0[2], v0[3]); w.z = cvt_pk_bf16(v1[0], v1[1]); w.w = cvt_pk_bf16(v1[2], v1[3]);
                            *(u32x4*)(rowp + bj * HALF) = w; } }
            } else {
                bf16_t* base = ((u.pm * BM) >> 13) ? VTS1 : VTS0; const int ldt = SEQ, rowi = ((u.pm * BM) & (SEQ - 1)) + wr * 64 + fr, col0 = (u.pn - vt_lo) * BM + wc * 32 + 8 * fq;
#pragma unroll
                for (int ai = 0; ai < 2; ++ai)
#pragma unroll
                    for (int m = 0; m < 4; ++m) { const int row = rowi + ai * HALF + m * 16;
                        const float rs_ = ss_in ? rsqrtf(ss_in[row0 + ai * HALF + m * 16] * (1.f / DM) + EPS) : 1.f;
#pragma unroll
                        for (int bj = 0; bj < 2; ++bj)
#pragma unroll
                            for (int n = 0; n < 2; ++n)
#pragma unroll
                                for (int j = 0; j < 4; ++j) base[(size_t)(col0 + bj * HALF + 4 * n + j) * ldt + row] = (bf16_t)f2bf(acc[ai][bj][m][n][j] * rs_); }
            }
        } else {
            const int row0 = u.pm * BM + wr * 64 + fr, col0 = u.pn * BM + wc * 32 + 8 * fq;
#pragma unroll
            for (int ai = 0; ai < 2; ++ai)
#pragma unroll
                for (int m = 0; m < 4; ++m) { const int row = row0 + ai * HALF + m * 16;
#pragma unroll
                    for (int bj = 0; bj < 2; ++bj) { const int col = col0 + bj * HALF;
                        const u32x4 gv = *(const u32x4*)(gate + (size_t)row * LDU_E + col);
                        const f32x4 s0 = *(const f32x4*)(pscale + col), s1 = *(const f32x4*)(pscale + col + 4);
                        const f32x4 v0 = acc[ai][bj][m][0], v1 = acc[ai][bj][m][1];
                        u32x4 w;
                        w.x = pk2(v0[0] * s0[0] * silu(bflo(gv.x)), v0[1] * s0[1] * silu(bfhi(gv.x)));
                        w.y = pk2(v0[2] * s0[2] * silu(bflo(gv.y)), v0[3] * s0[3] * silu(bfhi(gv.y)));
                        w.z = pk2(v1[0] * s1[0] * silu(bflo(gv.z)), v1[1] * s1[1] * silu(bfhi(gv.z)));
                        w.w = pk2(v1[2] * s1[2] * silu(bflo(gv.w)), v1[3] * s1[3] * silu(bfhi(gv.w)));
                        *(u32x4*)(O + (size_t)row * ldc + col) = w; } }
        }
    }
    DI void softmax_store(f32x4 (&acc)[2][2][4][2], const Unit& u, int wr, int wc, int fr, int fq, LAS unsigned char* lds) const {
        LAS float* ex = (LAS float*)lds;
        const float scl2 = 0.06375871541229934f;
        const int rloc = wr * 64 + fr;
        float mloc[2][4];
#pragma unroll
        for (int ai = 0; ai < 2; ++ai)
#pragma unroll
            for (int m = 0; m < 4; ++m) { const int rl = rloc + ai * HALF + m * 16;
                const float rs_ = rsqrtf(ss_in[u.pm * BM + rl] * (1.f / DM) + EPS) * scl2;
                float mx = -3.0e38f;
#pragma unroll
                for (int bj = 0; bj < 2; ++bj)
#pragma unroll
                    for (int n = 0; n < 2; ++n)
#pragma unroll
                        for (int j = 0; j < 4; ++j) { const float v = acc[ai][bj][m][n][j] * rs_; acc[ai][bj][m][n][j] = v; mx = fmaxf(mx, v); }
                mx = fmaxf(mx, __shfl_xor(mx, 16)); mx = fmaxf(mx, __shfl_xor(mx, 32));
                float sm = 0.f;
#pragma unroll
                for (int bj = 0; bj < 2; ++bj)
#pragma unroll
                    for (int n = 0; n < 2; ++n)
#pragma unroll
                        for (int j = 0; j < 4; ++j) { const float e = __builtin_amdgcn_exp2f(acc[ai][bj][m][n][j] - mx); acc[ai][bj][m][n][j] = e; sm += e; }
                sm += __shfl_xor(sm, 16); sm += __shfl_xor(sm, 32);
                mloc[ai][m] = mx;
                if (fq == 0) { ex[(rl * 4 + wc) * 2] = mx; ex[(rl * 4 + wc) * 2 + 1] = sm; } }
        __syncthreads();
#pragma unroll
        for (int ai = 0; ai < 2; ++ai)
#pragma unroll
            for (int m = 0; m < 4; ++m) { const int rl = rloc + ai * HALF + m * 16;
                const f32x4 p0 = *(const LAS f32x4*)(ex + rl * 8), p1 = *(const LAS f32x4*)(ex + rl * 8 + 4);
                const float M = fmaxf(fmaxf(p0[0], p0[2]), fmaxf(p1[0], p1[2]));
                const float tot = p0[1] * __builtin_amdgcn_exp2f(p0[0] - M) + p0[3] * __builtin_amdgcn_exp2f(p0[2] - M) + p1[1] * __builtin_amdgcn_exp2f(p1[0] - M) + p1[3] * __builtin_amdgcn_exp2f(p1[2] - M);
                const float f = __builtin_amdgcn_exp2f(mloc[ai][m] - M) / tot;
                bf16_t* rowp = O + (size_t)(u.pm * BM + rl) * ldc + u.pn * BM + wc * 32 + 8 * fq;
#pragma unroll
                for (int bj = 0; bj < 2; ++bj) { const f32x4 v0 = acc[ai][bj][m][0] * f, v1 = acc[ai][bj][m][1] * f;
                    u32x4 w; w.x = cvt_pk_bf16(v0[0], v0[1]); w.y = cvt_pk_bf16(v0[2], v0[3]); w.z = cvt_pk_bf16(v1[0], v1[1]); w.w = cvt_pk_bf16(v1[2], v1[3]);
                    *(u32x4*)(rowp + bj * HALF) = w; } }
    }
};

DI void gemm_phase(LAS unsigned char* lds, const Sched& S, const Epi& Ep) {
    const int tid = opq_tid(), wid = __builtin_amdgcn_readfirstlane(tid >> 6), lane = tid & 63, wr = wid >> 2, wc = wid & 3, fr = lane & 15, fq = lane >> 4;
    const int K = S.K, nt = K / BK;
    unsigned voffA[2], voffB[2];
#pragma unroll
    for (int i = 0; i < 2; ++i) { int R, C; stage_rc(tid * 16 + i * 8192, R, C); const int Rb = Ep.PERM ? ((R & ~31) + perm32(R & 31)) : R;
        voffA[i] = (unsigned)(R * S.lda + C) * 2u; voffB[i] = (unsigned)(Rb * S.ldb + C) * 2u; }
    const size_t kstep = (size_t)(BK * 2);
    const size_t hstepA = (size_t)HALF * S.lda * 2, hstepB = (size_t)HALF * S.ldb * 2;
    const unsigned ldsw = (unsigned)wid * 1024u;
    const int aoff = lds_byte(wr * 64 + fr, fq * 8), boff = lds_byte(wc * 32 + fr, fq * 8);
#define PG8_SA(b, h) (((b) * 2 + (h)) * HTB)
#define PG8_SB(b, h) ((4 + (b) * 2 + (h)) * HTB)
#define PG8_STAGE(bufoff, gbase, voff) do { _Pragma("unroll") for (int _i = 0; _i < 2; ++_i) \
        __builtin_amdgcn_global_load_lds((const unsigned*)((const char*)(gbase) + (voff)[_i]), (LAS unsigned*)(lds + (bufoff) + ldsw + _i * 8192), 16, 0, 0); } while (0)
#define PG8_LDA(dst, b, h) do { _Pragma("unroll") for (int m = 0; m < 4; ++m) _Pragma("unroll") for (int k = 0; k < 2; ++k) dst[m][k] = *(const LAS bf16x8*)(lds + PG8_SA(b, h) + aoff + m * 2048 + k * 1024); } while (0)
#define PG8_LDB(dst, b, h) do { _Pragma("unroll") for (int n = 0; n < 2; ++n) _Pragma("unroll") for (int k = 0; k < 2; ++k) dst[n][k] = *(const LAS bf16x8*)(lds + PG8_SB(b, h) + boff + n * 2048 + k * 1024); } while (0)
#define PG8_MMA(ai, bj, At, Bt) do { __builtin_amdgcn_s_setprio(1); _Pragma("unroll") for (int m = 0; m < 4; ++m) _Pragma("unroll") for (int n = 0; n < 2; ++n) _Pragma("unroll") for (int k = 0; k < 2; ++k) \
        acc[ai][bj][m][n] = __builtin_amdgcn_mfma_f32_16x16x32_bf16(Bt[n][k], At[m][k], acc[ai][bj][m][n], 0, 0, 0); __builtin_amdgcn_s_setprio(0); } while (0)
#define PG8_WAIT_V(n) asm volatile("s_waitcnt vmcnt(" #n ")" ::: "memory")
#define PG8_WAIT_L(n) asm volatile("s_waitcnt lgkmcnt(" #n ")" ::: "memory")
#define PG8_BAR __builtin_amdgcn_s_barrier()
#define PG8_SCHED __builtin_amdgcn_sched_barrier(0)
    Unit cur, nxt; int ui = 0;
    if (!S.next(0, cur)) return;
    f32x4 acc[2][2][4][2];
#pragma unroll
    for (int a = 0; a < 2; ++a)
#pragma unroll
        for (int b = 0; b < 2; ++b)
#pragma unroll
            for (int m = 0; m < 4; ++m)
#pragma unroll
                for (int n = 0; n < 2; ++n) acc[a][b][m][n] = (f32x4){0.f, 0.f, 0.f, 0.f};
    bf16x8 At[4][2], B0[2][2], B1[2][2];
    const char* cA = S.pa(cur); const char* cB = S.pb(cur);
    PG8_STAGE(PG8_SB(0, 0), cB, voffB); PG8_STAGE(PG8_SB(0, 1), cB + hstepB, voffB); PG8_STAGE(PG8_SA(0, 0), cA, voffA); PG8_STAGE(PG8_SA(0, 1), cA + hstepA, voffA);
    if (wr == 1) PG8_BAR;
    PG8_WAIT_V(2); PG8_BAR;
    PG8_STAGE(PG8_SB(1, 0), cB + kstep, voffB); PG8_STAGE(PG8_SA(1, 0), cA + kstep, voffA); PG8_STAGE(PG8_SB(1, 1), cB + hstepB + kstep, voffB);
    PG8_WAIT_V(6); PG8_BAR;
    const bool align_epi = (Ep.MODE != 3);
    for (;;) {
        const bool has_next = S.next(ui + 1, nxt);
        const char* nA = has_next ? S.pa(nxt) : cA; const char* nB = has_next ? S.pb(nxt) : cB;
        for (int t = 0; t < nt; t += 2) {
            const bool last = (t == nt - 2);
            const char* a1 = cA + (size_t)(t + 1) * kstep;
            const char* a2 = last ? nA : cA + (size_t)(t + 2) * kstep; const char* b2 = last ? nB : cB + (size_t)(t + 2) * kstep;
            const char* a3 = a2 + kstep; const char* b3 = b2 + kstep;
            PG8_LDB(B0, 0, 0); PG8_LDB(B1, 0, 1); PG8_SCHED; PG8_LDA(At, 0, 0); PG8_STAGE(PG8_SA(1, 1), a1 + hstepA, voffA);
            PG8_WAIT_V(8); PG8_WAIT_L(0); PG8_BAR; PG8_MMA(0, 0, At, B0); PG8_MMA(0, 1, At, B1); PG8_BAR; PG8_SCHED;
            PG8_LDA(At, 0, 1); PG8_STAGE(PG8_SB(0, 0), b2, voffB); PG8_STAGE(PG8_SB(0, 1), b2 + hstepB, voffB); PG8_STAGE(PG8_SA(0, 0), a2, voffA);
            PG8_WAIT_V(8); PG8_WAIT_L(0); PG8_BAR; PG8_MMA(1, 0, At, B0); PG8_MMA(1, 1, At, B1); PG8_BAR; PG8_SCHED;
            PG8_LDB(B0, 1, 0); PG8_LDB(B1, 1, 1); PG8_SCHED; PG8_LDA(At, 1, 0); PG8_STAGE(PG8_SA(0, 1), a2 + hstepA, voffA);
            PG8_WAIT_V(8); PG8_WAIT_L(0); PG8_BAR; PG8_MMA(0, 0, At, B0); PG8_MMA(0, 1, At, B1); PG8_BAR; PG8_SCHED;
            PG8_LDA(At, 1, 1); PG8_STAGE(PG8_SB(1, 0), b3, voffB); PG8_STAGE(PG8_SB(1, 1), b3 + hstepB, voffB); PG8_STAGE(PG8_SA(1, 0), a3, voffA);
            PG8_WAIT_V(8); PG8_WAIT_L(0); PG8_BAR; PG8_MMA(1, 0, At, B0); PG8_MMA(1, 1, At, B1); PG8_BAR; PG8_SCHED;
        }
        if (align_epi) { if (wr == 0) PG8_BAR; }
        if (Ep.MODE != 3) Ep(acc, cur, wr, wc, fr, fq);
        if (!has_next) break;
#pragma unroll
        for (int a = 0; a < 2; ++a)
#pragma unroll
            for (int b = 0; b < 2; ++b)
#pragma unroll
                for (int m = 0; m < 4; ++m)
#pragma unroll
                    for (int n = 0; n < 2; ++n) acc[a][b][m][n] = (f32x4){0.f, 0.f, 0.f, 0.f};
        cur = nxt; cA = nA; cB = nB; ++ui;
        if (align_epi) { if (wr == 1) PG8_BAR; }
    }
    PG8_WAIT_V(0);
    if (!align_epi) { if (wr == 0) PG8_BAR; }
    PG8_BAR;
    if (Ep.MODE == 3) Ep.softmax_store(acc, cur, wr, wc, fr, fq, lds);
#undef PG8_SA
#undef PG8_SB
#undef PG8_STAGE
#undef PG8_LDA
#undef PG8_LDB
#undef PG8_MMA
#undef PG8_WAIT_V
#undef PG8_WAIT_L
#undef PG8_BAR
#undef PG8_SCHED
}
}

DI void transpose_item(const float* W, int K, int N, bf16_t* WT, LAS float* scr, int item, int lane, const float* gk = nullptr) {
    const int nblk = N / 32, kb = item / nblk, nb = item % nblk, k0 = 64 * kb, n0 = 32 * nb;
#pragma unroll 8
    for (int i = 0; i < 32; ++i) { const int kk = 2 * i + (lane >> 5); scr[kk * 33 + (lane & 31)] = W[(size_t)(k0 + kk) * N + n0 + (lane & 31)] * (gk ? gk[k0 + kk] : 1.f); }
    asm volatile("s_waitcnt lgkmcnt(0)" ::: "memory");
    const int c = lane & 7;
#pragma unroll
    for (int j = 0; j < 4; ++j) { const int n = (lane >> 3) + 8 * j; const LAS float* s = scr + (8 * c) * 33 + n;
        u32x4 o; o.x = pk2(s[0 * 33], s[1 * 33]); o.y = pk2(s[2 * 33], s[3 * 33]); o.z = pk2(s[4 * 33], s[5 * 33]); o.w = pk2(s[6 * 33], s[7 * 33]);
        *(u32x4*)(WT + (size_t)(n0 + n) * K + k0 + 8 * c) = o; }
    asm volatile("s_waitcnt lgkmcnt(0)" ::: "memory");
}
DI void rms_row_bf16(const float* xrow, const float* g, bf16_t* orow, int lane) {
    const f32x4* xr = (const f32x4*)xrow + lane; const f32x4* gr = (const f32x4*)g + lane;
    f32x4 v[8]; float s = 0.f;
#pragma unroll
    for (int j = 0; j < 8; ++j) { v[j] = xr[64 * j]; s += (v[j].x * v[j].x + v[j].y * v[j].y) + (v[j].z * v[j].z + v[j].w * v[j].w); }
    const float r = rsqrtf(wave_sum(s) * (1.f / DM) + EPS);
    u32x2* o8 = (u32x2*)orow + lane;
#pragma unroll
    for (int j = 0; j < 8; ++j) { const f32x4 gg = gr[64 * j]; u32x2 w; w.x = pk2(v[j].x * r * gg.x, v[j].y * r * gg.y); w.y = pk2(v[j].z * r * gg.z, v[j].w * r * gg.w); o8[64 * j] = w; }
}
DI void rms_rows_phase(const float* X, const float* g, bf16_t* O, int nrows) {
    const int tid_ = opq_tid(), lane = tid_ & 63, gw = opq_bid() * 8 + (tid_ >> 6), NGW = gridDim.x * 8;
    for (int m = gw; m < nrows; m += NGW) rms_row_bf16(X + (size_t)m * DM, g, O + (size_t)m * DM, lane);
}

DI void prologue(const Params& P, LAS unsigned char* lds) {
    const int tid_ = opq_tid(), lane = tid_ & 63, wave = tid_ >> 6, gw = opq_bid() * 8 + wave, NGW = gridDim.x * 8;
    LAS float* scr = (LAS float*)(lds + wave * 16384);
    unsigned char* ws = P.ws;
    constexpr int I_INE = 32 * 192, I_SQ = 32 * 64, I_INO = 32 * 256, I_KV = 32 * 128, I_POOL = 4 * 8;
    constexpr int NITEMS = I_INE + I_SQ + I_INO + I_SQ + 2 * I_KV + 2 * I_SQ + 4 * I_POOL;
    for (int it = gw; it < NITEMS; it += NGW) {
        int r = it;
        if (r < I_INE) { transpose_item(P.w_in_e, DM, 6144, (bf16_t*)(ws + WS_WINE), scr, r, lane); continue; } r -= I_INE;
        if (r < I_SQ) { transpose_item(P.w_out_e, DM, DM, (bf16_t*)(ws + WS_WOUTE), scr, r, lane); continue; } r -= I_SQ;
        if (r < I_INO) { transpose_item(P.w_in_o, DM, 8192, (bf16_t*)(ws + WS_WINO), scr, r, lane, P.g_mix + DM); continue; } r -= I_INO;
        if (r < I_SQ) { transpose_item(P.w_out_o, DM, DM, (bf16_t*)(ws + WS_WOUTO), scr, r, lane); continue; } r -= I_SQ;
        if (r < 2 * I_KV) { const int l = r / I_KV; transpose_item(P.wkv + (size_t)l * DM * 4096, DM, 4096, (bf16_t*)(ws + WS_WKV) + (size_t)l * DM * 4096, scr, r % I_KV, lane); continue; } r -= 2 * I_KV;
        if (r < 2 * I_SQ) { const int l = r / I_SQ; transpose_item(P.wo + (size_t)l * DM * DM, DM, DM, (bf16_t*)(ws + WS_WO) + (size_t)l * DM * DM, scr, r % I_SQ, lane); continue; } r -= 2 * I_SQ;
        { const int g = r / I_POOL; transpose_item(P.pool_w + (size_t)g * 65536, 256, 256, (bf16_t*)(ws + WS_POOLT) + (size_t)g * 65536, scr, r % I_POOL, lane); }
    }
    { const f32x4* src = (const f32x4*)P.wq; u32x2* dst = (u32x2*)(ws + WS_WQ);
      for (int i = opq_bid() * NTH + tid_; i < 2 * DM * DM / 4; i += gridDim.x * NTH) { const float gr = P.g_xa[i >> 9]; const f32x4 v = src[i] * gr; u32x2 w; w.x = pk2(v.x, v.y); w.y = pk2(v.z, v.w); dst[i] = w; } }
    { float* ss = (float*)(ws + WS_SS); for (int i = opq_bid() * NTH + tid_; i < 4 * MT; i += gridDim.x * NTH) ss[i] = 0.f; }
    rms_rows_phase(P.x, P.g_mix, (bf16_t*)(ws + WS_XN), MT);
    for (int m = gw; m < 1024; m += NGW) { const int l = m >> 9, row = m & 511;
        rms_row_bf16(P.mem + (size_t)row * DM, P.g_mem + l * DM, (bf16_t*)(ws + WS_HM) + (size_t)m * DM, lane); }
}

template <int WIN> DI void pool_mix_group(const bf16_t* U, bf16_t* MIX, int g, size_t first, size_t stride) {
    const size_t NTOT = (size_t)MT * 32;
    for (size_t p = first; p < NTOT; p += stride) {
        const int t = (int)(p >> 5), c0 = g * 256 + (int)(p & 31) * 8, pos = t & (SEQ - 1);
        const int n = (pos + 1 < WIN) ? pos + 1 : WIN;
        const bf16_t* src = U + (size_t)t * LDU_E + c0;
        u32x4 v[WIN];
#pragma unroll
        for (int r = 0; r < WIN; ++r) v[r] = *(const u32x4*)(src - (size_t)(r < n ? r : 0) * LDU_E);
        float a[8] = {0.f, 0.f, 0.f, 0.f, 0.f, 0.f, 0.f, 0.f};
#pragma unroll
        for (int r = 0; r < WIN; ++r) { const float m = (r < n) ? 1.f : 0.f;
            a[0] += m * bflo(v[r].x); a[1] += m * bfhi(v[r].x); a[2] += m * bflo(v[r].y); a[3] += m * bfhi(v[r].y); a[4] += m * bflo(v[r].z); a[5] += m * bfhi(v[r].z); a[6] += m * bflo(v[r].w); a[7] += m * bfhi(v[r].w); }
        const float inv = 1.f / (float)n;
        u32x4 w; w.x = pk2(a[0] * inv - bflo(v[0].x), a[1] * inv - bfhi(v[0].x)); w.y = pk2(a[2] * inv - bflo(v[0].y), a[3] * inv - bfhi(v[0].y));
        w.z = pk2(a[4] * inv - bflo(v[0].z), a[5] * inv - bfhi(v[0].z)); w.w = pk2(a[6] * inv - bflo(v[0].w), a[7] * inv - bfhi(v[0].w));
        *(u32x4*)(MIX + (size_t)t * 1024 + c0) = w;
    }
}
DI void pool_mix_phase(const Params& P) {
    const bf16_t* U = (const bf16_t*)(P.ws + WS_U); bf16_t* MIX = (bf16_t*)(P.ws + WS_MIX);
    const size_t first = (size_t)opq_bid() * NTH + opq_tid(), stride = (size_t)gridDim.x * NTH;
    pool_mix_group<2>(U, MIX, 0, first, stride); pool_mix_group<4>(U, MIX, 1, first, stride); pool_mix_group<8>(U, MIX, 2, first, stride); pool_mix_group<16>(U, MIX, 3, first, stride);
}

constexpr int HG_KT = 17408, HG_IT = 27648, HG_P = 37888, HG_ST = 40448, HG_O = 75264, HG_DEC = 92160;
DI void tr_write8(LAS unsigned char* base, int row_stride_b, int col_b, int r0, const u32x4& v) {
    *(LAS bf16_t*)(base + (r0 + 0) * row_stride_b + col_b) = (bf16_t)(v.x & 0xffffu); *(LAS bf16_t*)(base + (r0 + 1) * row_stride_b + col_b) = (bf16_t)(v.x >> 16);
    *(LAS bf16_t*)(base + (r0 + 2) * row_stride_b + col_b) = (bf16_t)(v.y & 0xffffu); *(LAS bf16_t*)(base + (r0 + 3) * row_stride_b + col_b) = (bf16_t)(v.y >> 16);
    *(LAS bf16_t*)(base + (r0 + 4) * row_stride_b + col_b) = (bf16_t)(v.z & 0xffffu); *(LAS bf16_t*)(base + (r0 + 5) * row_stride_b + col_b) = (bf16_t)(v.z >> 16);
    *(LAS bf16_t*)(base + (r0 + 6) * row_stride_b + col_b) = (bf16_t)(v.w & 0xffffu); *(LAS bf16_t*)(base + (r0 + 7) * row_stride_b + col_b) = (bf16_t)(v.w >> 16);
}

DI void hgrn_passA(const Params& P, LAS unsigned char* lds, int u, bool skip_gates) {
    const int tid = opq_tid(), lane = tid & 63, w = tid >> 6, g = lane >> 4, r16 = lane & 15;
    const int b = u >> 8, h = (u >> 5) & 7, sc = u & 31, tok0 = b * SEQ + sc * 256, chunk0 = tok0 >> 5;
    bf16_t* U = (bf16_t*)(P.ws + WS_U); float* DEC = (float*)(P.ws + WS_DEC);
#pragma unroll 1
    for (int r = skip_gates ? 2 : 0; r < 2; ++r) {
        const int task = tid + NTH * r, ch = task >> 7, d = task & 127, cc = h * 128 + d;
        const float lbv = 1.f / (1.f + __expf(P.lb[1024 + cc] - P.lb[cc]));
        bf16_t* pq = U + (size_t)(tok0 + ch * 32) * LDU_E + 2048 + cc; bf16_t* pf = pq + 1024;
        bf16_t qraw[32], fraw[32];
#pragma unroll
        for (int s = 0; s < 32; ++s) { qraw[s] = pq[(size_t)s * LDU_E]; fraw[s] = pf[(size_t)s * LDU_E]; }
        float bc = 0.f;
#pragma unroll
        for (int s = 0; s < 32; ++s) {
            const float qv = bf2f(qraw[s]), fl = bf2f(fraw[s]);
            const float ex = __expf(-fl), sg = __builtin_amdgcn_rcpf(1.f + ex), f = lbv + (1.f - lbv) * sg, kk = (1.f - lbv) * (ex * sg);
            bc += __logf(f);
            pq[(size_t)s * LDU_E] = (bf16_t)(pk2(qv * __expf(bc), 0.f) & 0xffffu); pf[(size_t)s * LDU_E] = (bf16_t)(pk2(kk * __expf(-bc), 0.f) & 0xffffu);
        }
        DEC[(size_t)(chunk0 + ch) * 1024 + cc] = __expf(bc);
    }
    __syncthreads();
    f32x4 acc[8];
#pragma unroll
    for (int dt = 0; dt < 8; ++dt) acc[dt] = (f32x4){0.f, 0.f, 0.f, 0.f};
    const int row = tid & 31, seg = tid >> 5;
    const bf16_t* src = U + (size_t)(tok0 + row) * LDU_E + h * 128 + seg * 8;
    u32x4 rk = *(const u32x4*)(src + 3072), ri = *(const u32x4*)(src + 4096);
    float rdec = (tid < 128) ? DEC[(size_t)chunk0 * 1024 + h * 128 + tid] : 1.f, dtot = 1.f;
    LAS unsigned char* KT = lds; LAS unsigned char* IT = lds + 10240; LAS float* dec = (LAS float*)(lds + 20480);
    for (int ch = 0; ch < 8; ++ch) {
        tr_write8(KT, 80, row * 2, seg * 8, rk); tr_write8(IT, 80, row * 2, seg * 8, ri);
        if (tid < 128) { dec[tid] = rdec; dtot *= rdec; }
        if (ch < 7) { const bf16_t* s2 = src + (size_t)(ch + 1) * 32 * LDU_E; rk = *(const u32x4*)(s2 + 3072); ri = *(const u32x4*)(s2 + 4096);
            if (tid < 128) rdec = DEC[(size_t)(chunk0 + ch + 1) * 1024 + h * 128 + tid]; }
        __syncthreads();
        const bf16x8 bi = *(const LAS bf16x8*)(IT + (16 * w + r16) * 80 + g * 16);
#pragma unroll
        for (int dt = 0; dt < 8; ++dt) {
            const bf16x8 a = *(const LAS bf16x8*)(KT + (16 * dt + r16) * 80 + g * 16);
            acc[dt] = mfma16(a, bi, acc[dt]);
            const f32x4 dv = *(const LAS f32x4*)(dec + 16 * dt + 4 * g);
            acc[dt] *= dv;
        }
        __syncthreads();
    }
    float* SE = (float*)(P.ws + WS_SE) + (size_t)u * 16384;
#pragma unroll
    for (int dt = 0; dt < 8; ++dt)
#pragma unroll
        for (int j = 0; j < 4; ++j) SE[(16 * dt + 4 * g + j) * 128 + 16 * w + r16] = acc[dt][j];
    if (tid < 128) ((float*)(P.ws + WS_DT))[u * 128 + tid] = dtot;
}

DI void hgrn_scan_phase(const Params& P) {
    float* SE = (float*)(P.ws + WS_SE); const float* DT = (const float*)(P.ws + WS_DT);
    const int NT = gridDim.x * NTH;
    for (int e = opq_bid() * NTH + opq_tid(); e < 16 * 16384; e += NT) {
        const int bh = e >> 14, idx = e & 16383, d = idx >> 7;
        float S = 0.f;
#pragma unroll 8
        for (int sc = 0; sc < 32; ++sc) { const int u = bh * 32 + sc; const float tmp = SE[(size_t)u * 16384 + idx]; SE[(size_t)u * 16384 + idx] = S; S = DT[u * 128 + d] * S + tmp; }
    }
}

DI void hgrn_passC(const Params& P, LAS unsigned char* lds, int u) {
    const int tid = opq_tid(), lane = tid & 63, w = tid >> 6, g = lane >> 4, r16 = lane & 15;
    const int b = u >> 8, h = (u >> 5) & 7, sc = u & 31, tok0 = b * SEQ + sc * 256, chunk0 = tok0 >> 5;
    const bf16_t* U = (const bf16_t*)(P.ws + WS_U); const float* DEC = (const float*)(P.ws + WS_DEC);
    bf16_t* Y = (bf16_t*)(P.ws + WS_XN);
    LAS unsigned char* Qs = lds; LAS unsigned char* Ks = lds + 8704; LAS unsigned char* KT = lds + HG_KT; LAS unsigned char* IT = lds + HG_IT;
    LAS unsigned char* Ps = lds + HG_P; LAS unsigned char* ST = lds + HG_ST; LAS float* Os = (LAS float*)(lds + HG_O); LAS float* dec = (LAS float*)(lds + HG_DEC);
    f32x4 acc[8];
    { const float* SEb = (const float*)(P.ws + WS_SE); const float* DTb = (const float*)(P.ws + WS_DT);
      f32x4 W[8];
#pragma unroll
      for (int dt = 0; dt < 8; ++dt) { acc[dt] = (f32x4){0.f, 0.f, 0.f, 0.f}; W[dt] = (f32x4){1.f, 1.f, 1.f, 1.f}; }
#pragma unroll 1
      for (int jj = sc - 1; jj >= 0; --jj) {
          const int uj = (u - sc) + jj; const float* SE = SEb + (size_t)uj * 16384; const float* DT = DTb + uj * 128;
          float wmax = 0.f;
#pragma unroll
          for (int dt = 0; dt < 8; ++dt) {
              const f32x4 dv = *(const f32x4*)(DT + 16 * dt + 4 * g);
#pragma unroll
              for (int j = 0; j < 4; ++j) acc[dt][j] += W[dt][j] * SE[(16 * dt + 4 * g + j) * 128 + 16 * w + r16];
              W[dt] *= dv; wmax = fmaxf(wmax, fmaxf(fmaxf(W[dt][0], W[dt][1]), fmaxf(W[dt][2], W[dt][3]))); }
          if (!__any(wmax > 0.f)) break;
      }
#pragma unroll
      for (int dt = 0; dt < 8; ++dt) {
          u32x2 pw; pw.x = pk2(acc[dt][0], acc[dt][1]); pw.y = pk2(acc[dt][2], acc[dt][3]);
          *(LAS u32x2*)(ST + (16 * w + r16) * 272 + (16 * dt + 4 * g) * 2) = pw; } }
    const int row = tid & 31, seg = tid >> 5;
    const bf16_t* src = U + (size_t)(tok0 + row) * LDU_E + h * 128 + seg * 8;
    u32x4 rq = *(const u32x4*)(src + 2048), rk = *(const u32x4*)(src + 3072), ri = *(const u32x4*)(src + 4096);
    float rdec = (tid < 128) ? DEC[(size_t)chunk0 * 1024 + h * 128 + tid] : 1.f;
    const int nc = tid >> 4, nv0 = (tid & 15) * 8;
    f32x4 ng0 = *(const f32x4*)(P.hg + h * 128 + nv0), ng1 = *(const f32x4*)(P.hg + h * 128 + nv0 + 4);
    for (int ch = 0; ch < 8; ++ch) {
        *(LAS u32x4*)(Qs + row * 272 + seg * 16) = rq; *(LAS u32x4*)(Ks + row * 272 + seg * 16) = rk;
        tr_write8(KT, 80, row * 2, seg * 8, rk); tr_write8(IT, 80, row * 2, seg * 8, ri);
        if (tid < 128) dec[tid] = rdec;
        if (ch < 7) { const bf16_t* s2 = src + (size_t)(ch + 1) * 32 * LDU_E; rq = *(const u32x4*)(s2 + 2048); rk = *(const u32x4*)(s2 + 3072); ri = *(const u32x4*)(s2 + 4096);
            if (tid < 128) rdec = DEC[(size_t)(chunk0 + ch + 1) * 1024 + h * 128 + tid]; }
        const u32x4 gv = *(const u32x4*)(U + (size_t)(tok0 + ch * 32 + nc) * LDU_E + 5120 + h * 128 + nv0);
        __syncthreads();
        f32x4 ao[2];
#pragma unroll
        for (int ci = 0; ci < 2; ++ci) { ao[ci] = (f32x4){0.f, 0.f, 0.f, 0.f};
#pragma unroll
            for (int ks = 0; ks < 4; ++ks) { const bf16x8 a = *(const LAS bf16x8*)(Qs + (16 * ci + r16) * 272 + (32 * ks + 8 * g) * 2);
                const bf16x8 bs = *(const LAS bf16x8*)(ST + (16 * w + r16) * 272 + (32 * ks + 8 * g) * 2);
                ao[ci] = mfma16(a, bs, ao[ci]); } }
        if (w < 4) { const int ci = w >> 1, si = w & 1; f32x4 s = (f32x4){0.f, 0.f, 0.f, 0.f};
#pragma unroll
            for (int ks = 0; ks < 4; ++ks) { const bf16x8 a = *(const LAS bf16x8*)(Qs + (16 * ci + r16) * 272 + (32 * ks + 8 * g) * 2);
                const bf16x8 bk = *(const LAS bf16x8*)(Ks + (16 * si + r16) * 272 + (32 * ks + 8 * g) * 2);
                s = mfma16(a, bk, s); }
#pragma unroll
            for (int j = 0; j < 4; ++j) { const int c = 16 * ci + 4 * g + j, sidx = 16 * si + r16;
                *(LAS bf16_t*)(Ps + c * 80 + sidx * 2) = (bf16_t)f2bf(sidx <= c ? s[j] : 0.f); } }
        __syncthreads();
        const bf16x8 bi = *(const LAS bf16x8*)(IT + (16 * w + r16) * 80 + g * 16);
#pragma unroll
        for (int ci = 0; ci < 2; ++ci) { const bf16x8 a = *(const LAS bf16x8*)(Ps + (16 * ci + r16) * 80 + g * 16);
            ao[ci] = mfma16(a, bi, ao[ci]);
#pragma unroll
            for (int j = 0; j < 4; ++j) Os[(16 * ci + 4 * g + j) * 132 + 16 * w + r16] = ao[ci][j]; }
#pragma unroll
        for (int dt = 0; dt < 8; ++dt) {
            const bf16x8 a = *(const LAS bf16x8*)(KT + (16 * dt + r16) * 80 + g * 16);
            acc[dt] = mfma16(a, bi, acc[dt]);
            const f32x4 dv = *(const LAS f32x4*)(dec + 16 * dt + 4 * g);
            acc[dt] *= dv;
            u32x2 pw; pw.x = pk2(acc[dt][0], acc[dt][1]); pw.y = pk2(acc[dt][2], acc[dt][3]);
            *(LAS u32x2*)(ST + (16 * w + r16) * 272 + (16 * dt + 4 * g) * 2) = pw;
        }
        __syncthreads();
        { const f32x4 o0 = *(const LAS f32x4*)(Os + nc * 132 + nv0), o1 = *(const LAS f32x4*)(Os + nc * 132 + nv0 + 4);
          float ss = (o0.x * o0.x + o0.y * o0.y) + (o0.z * o0.z + o0.w * o0.w) + (o1.x * o1.x + o1.y * o1.y) + (o1.z * o1.z + o1.w * o1.w);
          ss += __shfl_xor(ss, 1); ss += __shfl_xor(ss, 2); ss += __shfl_xor(ss, 4); ss += __shfl_xor(ss, 8);
          const float r = rsqrtf(ss * (1.f / 128.f) + EPS);
          u32x4 wv;
          wv.x = pk2(o0.x * r * ng0.x * silu(bflo(gv.x)), o0.y * r * ng0.y * silu(bfhi(gv.x)));
          wv.y = pk2(o0.z * r * ng0.z * silu(bflo(gv.y)), o0.w * r * ng0.w * silu(bfhi(gv.y)));
          wv.z = pk2(o1.x * r * ng1.x * silu(bflo(gv.z)), o1.y * r * ng1.y * silu(bfhi(gv.z)));
          wv.w = pk2(o1.z * r * ng1.z * silu(bflo(gv.w)), o1.w * r * ng1.w * silu(bfhi(gv.w)));
          *(u32x4*)(Y + (size_t)(tok0 + ch * 32 + nc) * DM + 1024 + h * 128 + nv0) = wv; }
    }
    __syncthreads();
}

constexpr size_t WS_VTS0 = 1 * MiB, WS_VTS1 = 470 * MiB;
constexpr int SB_VOFF = 52224, SB_FLAGS = 103424;
constexpr float SB_RDONE = 150.0403f;
template <bool MASK>
DI void sb_block(const LAS unsigned char* kb, const LAS unsigned char* vb, int koff, int s0, int tq, const bf16x8 (&qb)[4], f32x4 (&o)[8], float& R, int g, int r16) {
    const float scl2 = 0.12751743082459868f;
    f32x4 z[2];
#pragma unroll
    for (int kt = 0; kt < 2; ++kt) { z[kt] = (f32x4){0.f, 0.f, 0.f, 0.f};
#pragma unroll
        for (int ks = 0; ks < 4; ++ks) { const bf16x8 a = *(const LAS bf16x8*)(kb + (koff + 16 * kt + r16) * 272 + (32 * ks + 8 * g) * 2); z[kt] = mfma16(a, qb[ks], z[kt]); } }
    float suf[2][4], TT[2];
#pragma unroll
    for (int kt = 0; kt < 2; ++kt) {
        float sp[4];
#pragma unroll
        for (int j = 0; j < 4; ++j) { const float zz = z[kt][j] * scl2; z[kt][j] = zz;
            const float v = fmaxf(zz, 0.f) + __builtin_amdgcn_logf(1.f + __builtin_amdgcn_exp2f(-fabsf(zz)));
            sp[j] = (!MASK || (s0 + 16 * kt + 4 * g + j < tq)) ? v : 0.f; }
        const float s3 = sp[3], s2 = sp[2] + s3, s1 = sp[1] + s2, s0_ = sp[0] + s1;
        const float o16 = __shfl_xor(s0_, 16), a2 = s0_ + o16, b2 = __shfl_xor(a2, 32);
        const float E = ((g & 1) == 0 ? o16 : 0.f) + (g < 2 ? b2 : 0.f);
        TT[kt] = a2 + b2; suf[kt][0] = s0_ + E; suf[kt][1] = s1 + E; suf[kt][2] = s2 + E; suf[kt][3] = s3 + E;
    }
    float base = R; float aw[2][4];
#pragma unroll
    for (int kt = 1; kt >= 0; --kt) {
#pragma unroll
        for (int j = 0; j < 4; ++j) { const float v = __builtin_amdgcn_exp2f(z[kt][j] - (base + suf[kt][j])); aw[kt][j] = (!MASK || (s0 + 16 * kt + 4 * g + j < tq)) ? v : 0.f; }
        base += TT[kt]; }
    R = base;
    u32x4 t; t.x = pk2(aw[0][0], aw[0][1]); t.y = pk2(aw[0][2], aw[0][3]); t.z = pk2(aw[1][0], aw[1][1]); t.w = pk2(aw[1][2], aw[1][3]); const bf16x8 bop = __builtin_bit_cast(bf16x8, t);
#pragma unroll
    for (int vt = 0; vt < 8; ++vt) { const LAS unsigned char* ap = vb + (16 * vt + r16) * 400 + (koff + 4 * g) * 2;
        const bf16x8 a = cat4(*(const LAS s16x4*)ap, *(const LAS s16x4*)(ap + 32)); o[vt] = mfma16(a, bop, o[vt]); }
}
DI void sb_phase(const Params& P, LAS unsigned char* lds) {
    const int tid = opq_tid(), lane = tid & 63, w = tid >> 6, g = lane >> 4, r16 = lane & 15;
    const int bid = opq_bid(), G = gridDim.x;
    const bf16_t* Uall = (const bf16_t*)(P.ws + WS_U); bf16_t* Yall = (bf16_t*)(P.ws + WS_XN);
    LAS int* flags = (LAS int*)(lds + SB_FLAGS);
    u32x4 rk[6], rv[6]; bf16x8 qn[4];
#define SB_LOAD(uu, rr) do { const int qt_ = (uu) & 63, bh_ = (uu) >> 6, b_ = bh_ >> 4, h_ = bh_ & 15, ks_ = qt_ * 128 + 128 - 192 * ((rr) + 1); \
        const bf16_t* Ub_ = Uall + (size_t)b_ * SEQ * LDU_O + 2048 + h_ * 128; const bf16_t* Vb_ = (const bf16_t*)(P.ws + (b_ ? WS_VTS1 : WS_VTS0)) + (size_t)h_ * 128 * SEQ; \
        _Pragma("unroll") for (int i = 0; i < 6; ++i) { const int p = tid + NTH * i; int kg = ks_ + (p >> 4); kg = kg < 0 ? 0 : kg; rk[i] = *(const u32x4*)(Ub_ + (size_t)kg * LDU_O + (p & 15) * 8); \
            const int v_ = p / 24, sg_ = p - 24 * v_; int kc = ks_ + sg_ * 8; kc = kc < 0 ? 0 : kc; rv[i] = *(const u32x4*)(Vb_ + (size_t)v_ * SEQ + kc); } } while (0)
#define SB_LOADQ(uu) do { const int qt_ = (uu) & 63, bh_ = (uu) >> 6, b_ = bh_ >> 4, h_ = bh_ & 15; const bf16_t* qp_ = Uall + ((size_t)b_ * SEQ + qt_ * 128 + 16 * w + r16) * LDU_O + h_ * 128 + 8 * g; \
        _Pragma("unroll") for (int ks = 0; ks < 4; ++ks) qn[ks] = *(const bf16x8*)(qp_ + 32 * ks); } while (0)
    int u = bid, r = 0;
    if (u >= 2048) return;
    SB_LOAD(u, 0); SB_LOADQ(u);
    bf16x8 qb[4]; f32x4 o[8]; float R = 0.f;
#pragma unroll
    for (int ks = 0; ks < 4; ++ks) qb[ks] = qn[ks];
#pragma unroll
    for (int vt = 0; vt < 8; ++vt) o[vt] = (f32x4){0.f, 0.f, 0.f, 0.f};
    for (;;) {
        const int qt = u & 63, bh = u >> 6, b = bh >> 4, h = bh & 15, t0 = qt * 128, tq = t0 + 16 * w + r16, twmax = t0 + 16 * w + 15;
        const int kstart = t0 + 128 - 192 * (r + 1);
#pragma unroll
        for (int i = 0; i < 6; ++i) { const int p = tid + NTH * i; *(LAS u32x4*)(lds + (p >> 4) * 272 + (p & 15) * 16) = rk[i];
            const int v_ = p / 24, sg_ = p - 24 * v_; *(LAS u32x4*)(lds + SB_VOFF + v_ * 400 + sg_ * 16) = rv[i]; }
        const bool spec_same = (r == 0) && (kstart > 0);
        const int nu = spec_same ? u : u + G, nr = spec_same ? 1 : 0;
        if (nu < 2048) { SB_LOAD(nu, nr); if (!spec_same) SB_LOADQ(nu); }
        __syncthreads();
#pragma unroll 1
        for (int hb = 5; hb >= 0; --hb) { const int s0 = kstart + 32 * hb;
            if (s0 < 0) break;
            if (s0 >= twmax) continue;
            if (__all(R > SB_RDONE)) break;
            if (s0 + 32 > twmax - 15) sb_block<true>(lds, lds + SB_VOFF, 32 * hb, s0, tq, qb, o, R, g, r16);
            else sb_block<false>(lds, lds + SB_VOFF, 32 * hb, s0, tq, qb, o, R, g, r16); }
        if (lane == 0) flags[w] = __all(R > SB_RDONE) ? 1 : 0;
        __syncthreads();
        if (spec_same) { r = 1; continue; }
        int alld = 1;
#pragma unroll
        for (int i = 0; i < 8; ++i) alld &= flags[i];
        if (alld || kstart <= 0) {
            { const bf16_t* gp = Uall + ((size_t)b * SEQ + tq) * LDU_O + 6144 + h * 128 + 4 * g; bf16_t* yp = (bf16_t*)Uall + ((size_t)b * SEQ + tq) * LDU_O + h * 128 + 4 * g;
#pragma unroll
              for (int vt = 0; vt < 8; ++vt) { const u32x2 gv = *(const u32x2*)(gp + 16 * vt);
                  u32x2 wv; wv.x = pk2(o[vt][0] * silu(bflo(gv.x)), o[vt][1] * silu(bfhi(gv.x))); wv.y = pk2(o[vt][2] * silu(bflo(gv.y)), o[vt][3] * silu(bfhi(gv.y)));
                  *(u32x2*)(yp + 16 * vt) = wv; } }
            u = nu; r = 0; R = 0.f;
            if (u >= 2048) break;
#pragma unroll
            for (int ks = 0; ks < 4; ++ks) qb[ks] = qn[ks];
#pragma unroll
            for (int vt = 0; vt < 8; ++vt) o[vt] = (f32x4){0.f, 0.f, 0.f, 0.f};
        } else {
            r = r + 1; SB_LOAD(u, r);
        }
    }
#undef SB_LOAD
#undef SB_LOADQ
    __syncthreads();
}

DI void final_norm_phase(const Params& P) {
    const int tid_ = opq_tid(), lane = tid_ & 63, gw = opq_bid() * 8 + (tid_ >> 6), NGW = gridDim.x * 8;
    const bf16_t* X = (const bf16_t*)(P.ws + WS_XN); const float* SS = (const float*)(P.ws + WS_SS) + 3 * MT;
    for (int mrow = gw; mrow < MT; mrow += NGW) {
        const u32x4* xr = (const u32x4*)(X + (size_t)mrow * DM) + lane; f32x4* orow = (f32x4*)(P.out + (size_t)mrow * DM); const f32x4* gr = (const f32x4*)P.g_fin;
        const float r = rsqrtf(SS[mrow] * (1.f / DM) + EPS);
        u32x4 v[4];
#pragma unroll
        for (int j = 0; j < 4; ++j) v[j] = xr[64 * j];
#pragma unroll
        for (int j = 0; j < 4; ++j) { const int c4 = (64 * j + lane) * 2; const f32x4 g0 = gr[c4], g1 = gr[c4 + 1];
            orow[c4] = (f32x4){bflo(v[j].x) * r * g0.x, bfhi(v[j].x) * r * g0.y, bflo(v[j].y) * r * g0.z, bfhi(v[j].y) * r * g0.w};
            orow[c4 + 1] = (f32x4){bflo(v[j].z) * r * g1.x, bfhi(v[j].z) * r * g1.y, bflo(v[j].w) * r * g1.z, bfhi(v[j].w) * r * g1.w}; }
    }
}

#define XB_TMO      128
#define XB_XCNT(j)  (256  + 64 * (j))
#define XB_XSUB(j)  (1280 + 64 * (j))
#define XB_XGEN(j)  (2304 + 64 * (j))
#define XB_TOP      3328
#define XB_TOPGEN   3392
#define XCD_BAR_WORDS 3456
#define XB_SPIN_CAP (1u << 18)
DI unsigned xb_ld(unsigned* p)              { return __hip_atomic_load(p, __ATOMIC_RELAXED, __HIP_MEMORY_SCOPE_AGENT); }
DI unsigned xb_add(unsigned* p, unsigned v) { return __hip_atomic_fetch_add(p, v, __ATOMIC_RELAXED, __HIP_MEMORY_SCOPE_AGENT); }
DI unsigned xb_xcc_id() { return (unsigned)__builtin_amdgcn_s_getreg((3 << 11) | 20) & 0xFu; }
#define XB_SPIN(cond, bar) do { unsigned _sp = 0; while (cond) { __builtin_amdgcn_s_sleep(1); \
    if ((++_sp & 255u) == 0u) { if (xb_ld(&(bar)[XB_TMO])) break; if (_sp > XB_SPIN_CAP) { atomicAdd(&(bar)[XB_TMO], 1u); break; } } } } while (0)
struct XcdBarrier { unsigned* bar; unsigned x; volatile LAS unsigned* st; };
DI XcdBarrier xcd_barrier_post(unsigned* bar, volatile LAS unsigned* st) {
    XcdBarrier b; b.bar = bar; b.x = xb_xcc_id(); b.st = st;
    if (threadIdx.x == 0) (void)xb_add(&bar[XB_XCNT(b.x)], 1u);
    return b;
}
DI void xcd_barrier_complete(unsigned* bar, unsigned x, unsigned& nloc, unsigned& nx) {
    const unsigned G = gridDim.x * gridDim.y * gridDim.z;
    unsigned sum, cnt, mine, sp = 0u;
    for (;;) {
        sum = 0u; cnt = 0u; mine = 0u;
#pragma unroll
        for (unsigned j = 0; j < 16; ++j) { const unsigned c = xb_ld(&bar[XB_XCNT(j)]); sum += c; cnt += (c > 0u) ? 1u : 0u; mine = (j == x) ? c : mine; }
        if (sum == G) break;
        __builtin_amdgcn_s_sleep(1);
        if ((++sp & 255u) == 0u) { if (xb_ld(&bar[XB_TMO])) break; if (sp > XB_SPIN_CAP) { atomicAdd(&bar[XB_TMO], 1u); break; } }
    }
    nloc = mine > 0u ? mine : 1u; nx = cnt > 0u ? cnt : 1u;
}
DI void xcd_barrier(const XcdBarrier& b) {
    asm volatile("s_waitcnt vmcnt(0)" ::: "memory");
    __syncthreads();
    if (threadIdx.x == 0) {
        unsigned* bar = b.bar;
        __builtin_amdgcn_s_waitcnt(0);
        unsigned nloc = b.st[0], nx = b.st[1];
        if (nloc == 0u) { xcd_barrier_complete(bar, b.x, nloc, nx); b.st[0] = nloc; b.st[1] = nx; }
        const unsigned old = xb_add(&bar[XB_XSUB(b.x)], 1u);
        const unsigned gen = old / nloc;
        if (old + 1u == (gen + 1u) * nloc) {
            __builtin_amdgcn_fence(__ATOMIC_RELEASE, "agent");
            asm volatile("s_waitcnt vmcnt(0)" ::: "memory");
            const unsigned og = xb_add(&bar[XB_TOP], 1u);
            const unsigned tg = og / nx;
            if (og + 1u == (tg + 1u) * nx) xb_add(&bar[XB_TOPGEN], 1u);
            else XB_SPIN(xb_ld(&bar[XB_TOPGEN]) == tg, bar);
            __builtin_amdgcn_fence(__ATOMIC_ACQUIRE, "agent");
            xb_add(&bar[XB_XGEN(b.x)], 1u);
            asm volatile("s_waitcnt vmcnt(0)" ::: "memory");
        } else {
            XB_SPIN(xb_ld(&bar[XB_XGEN(b.x)]) == gen, bar);
            __builtin_amdgcn_fence(__ATOMIC_ACQUIRE, "agent");
            asm volatile("s_waitcnt vmcnt(0)" ::: "memory");
        }
    }
    __syncthreads();
}

__global__ void __launch_bounds__(NTH, 2) fwd_megakernel(Params P0) {
    extern __shared__ __attribute__((aligned(16))) unsigned char lds_raw[];
    LAS unsigned char* lds = (LAS unsigned char*)lds_raw;
    cg::grid_group grid = cg::this_grid();
    if (threadIdx.x < 4) ((LAS unsigned*)(lds + LDS_BARST))[threadIdx.x] = 0u;
    __syncthreads();
    const XcdBarrier xbar = xcd_barrier_post((unsigned*)P0.ws, (volatile LAS unsigned*)(lds + LDS_BARST));
    const int G = gridDim.x, nph = P0.nph;

    if (nph < 0) grid.sync();
    constexpr unsigned GEMM_MASK = (1u << 1) | (1u << 2) | (1u << 4) | (1u << 5) | (1u << 7) | (1u << 9) | (1u << 11) | (1u << 13) | (1u << 15) | (1u << 17);
#pragma unroll 1
    for (int ph = 0; ph < nph; ++ph) {
        Params P = P0; { unsigned char* w_ = P0.ws; asm volatile("" : "+s"(w_)); P.ws = w_; }
        unsigned char* ws = P.ws; const int bid = opq_bid();
        bf16_t* XN = (bf16_t*)(ws + WS_XN); bf16_t* Ub = (bf16_t*)(ws + WS_U);
        if (ph == 3 || ph == 6 || ph == 8 || ph == 10 || ph == 14 || ph == 16) continue;
        const int nrep = ((PROBE_MASK >> ph) & 1u) ? 2 : 1;
        for (int rep = 0; rep < nrep; ++rep) {
        if (rep) __syncthreads();
        if (ph == 0) prologue(P, lds);
        else if (ph == 2) { pool_mix_phase(P); for (int u = bid; u < 512; u += G) hgrn_passA(P, lds, u, rep > 0); }
        else if (ph == 3) { if (rep == 0) hgrn_scan_phase(P); }
        else if (ph == 4) { for (int u = bid; u < 512; u += G) hgrn_passC(P, lds, u); }
        else if (ph == 12) sb_phase(P, lds);
        else if (ph == 18) final_norm_phase(P);
        if ((GEMM_MASK >> ph) & 1u) {
            pg8::Sched S; pg8::Epi E{};
            const int layer = (ph >= 12) ? 1 : 0;
            bf16_t* XN2 = (bf16_t*)(ws + WS_U + 64 * MiB);
            bf16_t* BtS = (bf16_t*)(ws + (layer ? 89 : 1) * MiB); bf16_t* BtN = (bf16_t*)(ws + (layer ? 97 : 9) * MiB);
            const bf16_t* A = (ph == 9 || ph == 13 || ph == 17) ? Ub : ((ph == 7) ? XN2 : XN); const bf16_t* Bt; int N = DM, K = DM, lda = DM, ldb = DM, apn = 0; long bbs = 0;
            E.MODE = (ph == 5 || ph == 9 || ph == 13 || ph == 17) ? 1 : (ph == 4 ? 2 : ((ph == 7 || ph == 15) ? 3 : 0)); E.PERM = true;
            E.O = Ub; E.ldc = DM; E.KX = (bf16_t*)(ws + WS_KX); E.VX = (bf16_t*)(ws + WS_VT); E.BtS = BtS; E.BtN = BtN; E.BtS1 = (bf16_t*)(ws + 89 * MiB); E.BtN1 = (bf16_t*)(ws + 97 * MiB); E.res = (ph == 5) ? P.x : nullptr; E.resb = (ph == 9) ? XN2 : ((ph == 13 || ph == 17) ? XN : nullptr); E.out = P.out; E.xr_out = (ph == 5) ? XN2 : XN; E.gate = Ub + 1024; E.pscale = P.pool_s;
            { float* SS = (float*)(ws + WS_SS); const int si = (ph == 5 || ph == 7) ? 0 : ((ph == 9 || ph == 11) ? 1 : ((ph == 17) ? 3 : 2));
              const bool prod = (ph == 5 || ph == 9 || ph == 13 || ph == 17), cons = (ph == 7 || ph == 11 || ph == 15);
              E.ss_out = prod ? SS + si * MT : nullptr; E.ss_in = cons ? SS + si * MT : nullptr; }
            E.vt_lo = (ph == 11) ? 16 : (1 << 20); E.VTS0 = (bf16_t*)(ws + WS_VTS0); E.VTS1 = (bf16_t*)(ws + WS_VTS1);
            if (ph == 1) { Bt = (const bf16_t*)(ws + WS_WINE); N = 6144; E.ldc = LDU_E; }
            else if (ph == 2) { Bt = nullptr; K = 512; }
            else if (ph == 4) { A = (const bf16_t*)(ws + WS_MIX); Bt = (const bf16_t*)(ws + WS_POOLT); N = 1024; K = 256; lda = 1024; ldb = 256; apn = 512; E.O = XN; }
            else if (ph == 5) Bt = (const bf16_t*)(ws + WS_WOUTE);
            else if (ph == 7 || ph == 15) { Bt = BtS; N = 1024; bbs = 1024L * DM; E.ldc = 1024; }
            else if (ph == 9 || ph == 17) { Bt = BtN; K = 1024; lda = 1024; ldb = 1024; bbs = 2048L * 1024; }
            else if (ph == 11) { Bt = (const bf16_t*)(ws + WS_WINO); N = 8192; E.ldc = LDU_O; }
            else { Bt = (const bf16_t*)(ws + WS_WOUTO); lda = LDU_O; }
            S.init(A, Bt, MT, N, K, lda, ldb, apn); S.b_batch_stride = bbs;
            if (ph == 1) { S.n_extra = 64; S.A2 = (const bf16_t*)(ws + WS_HM); S.B2 = (const bf16_t*)(ws + WS_WKV); }
            if (ph == 2) { S.pre = 1; S.KXl = (const bf16_t*)(ws + WS_KX); S.VXl = (const bf16_t*)(ws + WS_VT); S.WQp = (const bf16_t*)(ws + WS_WQ); S.WOt = (const bf16_t*)(ws + WS_WO); }
            pg8::gemm_phase(lds, S, E);
        }
        }
        if (ph + 1 < nph) xcd_barrier(xbar);
#ifdef PROBE_SYNCS
        if (ph == 5) { for (int i = 0; i < PROBE_SYNCS; ++i) xcd_barrier(xbar); }
#endif
    }
}

extern "C" void kernel_launch(void* const* d_in, const int* in_sizes, int n_in, void* d_out, int out_size, void* d_ws, size_t ws_size, hipStream_t stream) {
    static int grid = 0;
    if (grid == 0) {
        if (n_in != 17 || out_size != MT * DM || ws_size < WS_END) { fprintf(stderr, "kernel_launch: unexpected shapes (n_in %d out %d ws %zu)\n", n_in, out_size, ws_size); grid = -1; return; }
        int dev = 0, cus = 0, per_cu = 0;
        (void)hipGetDevice(&dev);
        (void)hipDeviceGetAttribute(&cus, hipDeviceAttributeMultiprocessorCount, dev);
        if (hipFuncSetAttribute((const void*)fwd_megakernel, hipFuncAttributeMaxDynamicSharedMemorySize, LDS_BYTES) != hipSuccess) { fprintf(stderr, "kernel_launch: hipFuncSetAttribute failed\n"); grid = -1; return; }
        if (hipOccupancyMaxActiveBlocksPerMultiprocessor(&per_cu, (const void*)fwd_megakernel, NTH, LDS_BYTES) != hipSuccess || per_cu < 1) { fprintf(stderr, "kernel_launch: occupancy query failed (%d)\n", per_cu); per_cu = 1; }
        (void)hipGetLastError();
        grid = cus * per_cu;
        fprintf(stderr, "kernel_launch: grid %d (cus %d x %d)\n", grid, cus, per_cu);
    }
    if (grid < 0) return;
    Params p{};
    const float** pp = (const float**)&p;
    for (int i = 0; i < 17; ++i) pp[i] = (const float*)d_in[i];
    p.out = (float*)d_out; p.ws = (unsigned char*)d_ws; p.nph = 19;
    if (hipMemsetAsync(d_ws, 0, 16384, stream) != hipSuccess) { fprintf(stderr, "kernel_launch: memset failed\n"); return; }
    void* args[] = {&p};
    hipError_t e = hipLaunchCooperativeKernel((const void*)fwd_megakernel, dim3(grid), dim3(NTH), args, LDS_BYTES, stream);
    if (e != hipSuccess) fprintf(stderr, "cooperative launch failed: %s (grid %d)\n", hipGetErrorString(e), grid);
}
```

```cpp
#include <hip/hip_runtime.h>
#include <hip/hip_cooperative_groups.h>
#include <cstdio>
namespace cg = cooperative_groups;

#define DI __device__ __forceinline__
#define LAS __attribute__((address_space(3)))
typedef unsigned short bf16_t;
typedef short bf16x8 __attribute__((ext_vector_type(8)));
typedef short s16x4 __attribute__((ext_vector_type(4)));
typedef float f32x4 __attribute__((ext_vector_type(4)));
typedef unsigned u32x4 __attribute__((ext_vector_type(4)));
typedef unsigned u32x2 __attribute__((ext_vector_type(2)));

constexpr int DM = 2048, SEQ = 8192, NBATCH = 2, MT = NBATCH * SEQ, MEMLEN = 256;
constexpr int NTH = 512, LDS_BYTES = 147456, LDS_BARST = 147440;
#ifndef PROBE_MASK
#define PROBE_MASK 0u
#endif
constexpr float EPS = 1e-6f;
constexpr int LDU_E = 6144, LDU_O = 8192;

constexpr size_t MiB = 1u << 20;
constexpr size_t WS_WINE = 1 * MiB, WS_WOUTE = 25 * MiB, WS_WINO = 33 * MiB, WS_WOUTO = 65 * MiB, WS_WQ = 73 * MiB, WS_WKV = 89 * MiB, WS_WO = 121 * MiB, WS_POOLT = 137 * MiB;
constexpr size_t WS_HM = 138 * MiB, WS_KX = 142 * MiB, WS_VT = 146 * MiB, WS_XN = 150 * MiB, WS_U = 214 * MiB;
constexpr size_t WS_MIX = 406 * MiB;
constexpr size_t WS_SE = 470 * MiB;
constexpr size_t WS_DT = 502 * MiB;
constexpr size_t WS_DEC = 503 * MiB;
constexpr size_t WS_SS = 502 * MiB + 512 * 1024;
constexpr size_t WS_END = 512 * MiB;

struct Params {
    const float *x, *mem, *g_mix, *g_xa, *g_mem, *g_fin, *w_in_e, *pool_w, *pool_s, *lb, *hg, *w_out_e, *w_in_o, *w_out_o, *wq, *wkv, *wo;
    float* out; unsigned char* ws; int nph, pad;
};

DI unsigned f2bf(float f) { unsigned u = __builtin_bit_cast(unsigned, f); return (u + 0x7fffu + ((u >> 16) & 1u)) >> 16; }
typedef __bf16 bf16x2_t __attribute__((ext_vector_type(2)));
typedef float f32x2_t __attribute__((ext_vector_type(2)));
DI unsigned pk2(float lo, float hi) { f32x2_t f = {lo, hi}; bf16x2_t v = __builtin_convertvector(f, bf16x2_t); return __builtin_bit_cast(unsigned, v); }
DI float bf2f(unsigned v) { return __builtin_bit_cast(float, v << 16); }
DI float bflo(unsigned w) { return __builtin_bit_cast(float, w << 16); }
DI float bfhi(unsigned w) { return __builtin_bit_cast(float, w & 0xffff0000u); }
DI float wave_sum(float v) {
#pragma unroll
    for (int o = 1; o < 64; o <<= 1) v += __shfl_xor(v, o);
    return v;
}
DI int opq_tid() { int t = threadIdx.x; asm volatile("" : "+v"(t)); return t; }
DI int opq_bid() { int b = blockIdx.x; asm volatile("" : "+s"(b)); return b; }
DI float silu(float v) { return v / (1.f + __expf(-v)); }
DI f32x4 mfma16(bf16x8 a, bf16x8 b, f32x4 c) { return __builtin_amdgcn_mfma_f32_16x16x32_bf16(a, b, c, 0, 0, 0); }
DI bf16x8 cat4(s16x4 lo, s16x4 hi) { return __builtin_shufflevector(lo, hi, 0, 1, 2, 3, 4, 5, 6, 7); }

namespace pg8 {
constexpr int BM = 256, BK = 64, HALF = 128, HTB = HALF * BK * 2, STAGE_BYTES = 8 * HTB, NXCD = 8, WGM = 8;
DI int lds_byte(int r, int c) { const int st = (r >> 4) * 2 + (c >> 5), rr = r & 15, cc = c & 31, ob = rr * 64 + cc * 2; return st * 1024 + (ob ^ (((ob >> 9) & 1) << 5)); }
DI void stage_rc(int b, int& R, int& C) { const int st = b / 1024, sb = b % 1024, swz = sb ^ (((sb >> 9) & 1) << 5); R = (st >> 1) * 16 + swz / 64; C = (st & 1) * 32 + (swz % 64) / 2; }
DI int perm32(int rho) { const int n = rho >> 4, i = rho & 15; return 8 * (i >> 2) + 4 * n + (i & 3); }
DI unsigned cvt_pk_bf16(float lo, float hi) { unsigned r; asm volatile("v_cvt_pk_bf16_f32 %0, %1, %2" : "=v"(r) : "v"(lo), "v"(hi)); return r; }

struct Unit { int pm, pn, gi; };
struct Sched {
    const bf16_t* A; const bf16_t* Bt; int lda, ldb, a_pn_bytes, K; long b_batch_stride;
    int nM, nN, nwg, G, c;
    int n_extra; const bf16_t* A2; const bf16_t* B2;
    int pre; const bf16_t* KXl; const bf16_t* VXl; const bf16_t* WQp; const bf16_t* WOt;
    DI void init(const bf16_t* A_, const bf16_t* Bt_, int M, int N, int K_, int lda_, int ldb_, int a_pn_bytes_) {
        A = A_; Bt = Bt_; lda = lda_; ldb = ldb_; a_pn_bytes = a_pn_bytes_; K = K_; b_batch_stride = 0; nM = M / BM; nN = N / BM; nwg = nM * nN; G = gridDim.x; c = opq_bid(); n_extra = 0; A2 = nullptr; B2 = nullptr;
        pre = 0; KXl = nullptr; VXl = nullptr; WQp = nullptr; WOt = nullptr;
    }
    DI bool next(int i, Unit& u) const {
        const long L = (long)i * G + c;
        const long total = pre ? 256 : (long)(nwg + n_extra);
        if (L >= total) return false;
        const bool ex = (!pre) && (L >= nwg); const int e = (int)(L - nwg), Li = (int)L;
        int wgid = (ex || pre) ? 0 : Li; { const int q = nwg / NXCD, r = nwg % NXCD, xcd = wgid % NXCD, off = wgid / NXCD; wgid = (xcd < r ? xcd * (q + 1) : r * (q + 1) + (xcd - r) * q) + off; }
        const int nig = WGM * nN, gid = wgid / nig, fm = gid * WGM, gsz = (nM - fm) < WGM ? (nM - fm) : WGM;
        const int pm0 = fm + ((wgid % nig) % gsz), pn0 = (wgid % nig) / gsz;
        u.pm = pre ? (Li & 7) : (ex ? ((e & 31) >> 4) : pm0);
        u.pn = pre ? ((Li >> 3) & 7) : (ex ? (e & 15) : pn0);
        u.gi = pre ? 3 + ((Li >> 6) & 1) + 2 * (Li >> 7) : (ex ? 1 + (e >> 5) : 0);
        return true;
    }
    DI const char* pa(const Unit& u) const {
        const int b = u.pn >> 2, h = u.pn & 3; const bf16_t* p;
        if (u.gi == 0) p = A + (size_t)u.pm * BM * (size_t)lda + (size_t)u.pn * (a_pn_bytes >> 1);
        else if (u.gi <= 2) p = A2 + ((size_t)(u.gi - 1) * 512 + (size_t)u.pm * BM) * (size_t)lda;
        else if (((u.gi - 3) & 1) == 0) p = KXl + (size_t)((u.gi - 3) >> 1) * 512 * DM + (size_t)(b * 256) * DM + h * 512;
        else p = WOt + (size_t)((u.gi - 3) >> 1) * DM * DM + (size_t)(u.pm * 256) * DM + h * 512;
        return (const char*)p;
    }
    DI const char* pb(const Unit& u) const {
        const int b = u.pn >> 2, h = u.pn & 3; const bf16_t* p;
        if (u.gi == 0) p = Bt + (size_t)(u.pm >> 5) * (size_t)b_batch_stride + (size_t)u.pn * BM * (size_t)ldb;
        else if (u.gi <= 2) p = B2 + ((size_t)(u.gi - 1) * 4096 + (size_t)u.pn * BM) * (size_t)ldb;
        else if (((u.gi - 3) & 1) == 0) p = WQp + (size_t)((u.gi - 3) >> 1) * DM * DM + (size_t)(u.pm * 256) * DM + h * 512;
        else p = VXl + (size_t)((u.gi - 3) >> 1) * 512 * DM + (size_t)(b * 256) * DM + h * 512;
        return (const char*)p;
    }
};

struct Epi {
    int MODE; bool PERM;
    bf16_t* O; int ldc;
    bf16_t* KX; bf16_t* VX;
    bf16_t* BtS1; bf16_t* BtN1; bf16_t* BtS; bf16_t* BtN;
    int vt_lo; bf16_t* VTS0; bf16_t* VTS1;
    const float* res; const bf16_t* resb; float* out; bf16_t* xr_out; float* ss_out;
    const float* ss_in;
    const bf16_t* gate; const float* pscale;
    DI void operator()(const f32x4 (&acc)[2][2][4][2], const Unit& u, int wr, int wc, int fr, int fq) const {
        if (MODE == 1) {
            const int row0 = u.pm * BM + wr * 64 + fr, col0 = u.pn * BM + wc * 32 + 8 * fq;
#pragma unroll
            for (int ai = 0; ai < 2; ++ai) {
                f32x4 rr[4][2][2];
                if (resb) {
                    u32x4 rb[4][2];
#pragma unroll
                    for (int m = 0; m < 4; ++m)
#pragma unroll
                        for (int bj = 0; bj < 2; ++bj) rb[m][bj] = *(const u32x4*)(resb + (size_t)(row0 + ai * HALF + m * 16) * DM + col0 + bj * HALF);
#pragma unroll
                    for (int m = 0; m < 4; ++m)
#pragma unroll
                        for (int bj = 0; bj < 2; ++bj) { rr[m][bj][0] = (f32x4){bflo(rb[m][bj].x), bfhi(rb[m][bj].x), bflo(rb[m][bj].y), bfhi(rb[m][bj].y)};
                            rr[m][bj][1] = (f32x4){bflo(rb[m][bj].z), bfhi(rb[m][bj].z), bflo(rb[m][bj].w), bfhi(rb[m][bj].w)}; }
                } else {
#pragma unroll
                    for (int m = 0; m < 4; ++m)
#pragma unroll
                        for (int bj = 0; bj < 2; ++bj)
#pragma unroll
                            for (int n = 0; n < 2; ++n) rr[m][bj][n] = *(const f32x4*)(res + (size_t)(row0 + ai * HALF + m * 16) * DM + col0 + bj * HALF + 4 * n);
                }
#pragma unroll
                for (int m = 0; m < 4; ++m) { const int row = row0 + ai * HALF + m * 16; const size_t ro = (size_t)row * DM + col0; float ssq = 0.f;
#pragma unroll
                    for (int bj = 0; bj < 2; ++bj) { const f32x4 v0 = acc[ai][bj][m][0] + rr[m][bj][0], v1 = acc[ai][bj][m][1] + rr[m][bj][1];
                        if (xr_out) { u32x4 w; w.x = pk2(v0[0], v0[1]); w.y = pk2(v0[2], v0[3]); w.z = pk2(v1[0], v1[1]); w.w = pk2(v1[2], v1[3]); *(u32x4*)(xr_out + ro + bj * HALF) = w; }
                        else { *(f32x4*)(out + ro + bj * HALF) = v0; *(f32x4*)(out + ro + bj * HALF + 4) = v1; }
                        ssq += ((v0[0] * v0[0] + v0[1] * v0[1]) + (v0[2] * v0[2] + v0[3] * v0[3])) + ((v1[0] * v1[0] + v1[1] * v1[1]) + (v1[2] * v1[2] + v1[3] * v1[3])); }
                    if (ss_out) { ssq += __shfl_xor(ssq, 16); ssq += __shfl_xor(ssq, 32); if (fq == 0) atomicAdd(ss_out + row, ssq); } }
            }
        } else if (MODE == 0) {
            const int row0 = u.pm * BM + wr * 64 + fr;
            const bool sbv = (u.gi == 0) && ((unsigned)(u.pn - vt_lo) < 8u);
            if (!sbv) {
                const int bb = u.pn >> 2, hh = u.pn & 3;
                bf16_t* base; int ld, rowb, colb;
                if (u.gi == 0) { base = O; ld = ldc; rowb = u.pm * BM; colb = u.pn * BM; }
                else if (u.gi <= 2) { base = ((u.pn >= 8) ? VX : KX) + (size_t)(u.gi - 1) * 512 * DM; ld = DM; rowb = u.pm * BM; colb = (u.pn & 7) * BM; }
                else if (((u.gi - 3) & 1) == 0) { base = ((u.gi >= 5) ? BtS1 : BtS) + (size_t)(bb * 1024 + hh * 256) * DM; ld = DM; rowb = 0; colb = u.pm * BM; }
                else { base = ((u.gi >= 5) ? BtN1 : BtN) + (size_t)(bb * 2048 + u.pm * 256) * 1024; ld = 1024; rowb = 0; colb = hh * 256; }
                const int rloc = wr * 64 + fr, col0 = colb + wc * 32 + 8 * fq;
#pragma unroll
                for (int ai = 0; ai < 2; ++ai)
#pragma unroll
                    for (int m = 0; m < 4; ++m) { bf16_t* rowp = base + (size_t)(rowb + rloc + ai * HALF + m * 16) * ld + col0;
                        const float rs_ = ss_in ? rsqrtf(ss_in[row0 + ai * HALF + m * 16] * (1.f / DM) + EPS) : 1.f;
#pragma unroll
                        for (int bj = 0; bj < 2; ++bj) { const f32x4 v0 = acc[ai][bj][m][0] * rs_, v1 = acc[ai][bj][m][1] * rs_;
                            u32x4 w; w.x = cvt_pk_bf16(v0[0], v0[1]); w.y = cvt_pk_bf16(v0[2], v0[3]); w.z = cvt_pk_bf16(v1[0], v1[1]); w.w = cvt_pk_bf16(v1[2], v1[3]);
                            *(u32x4*)(rowp + bj * HALF) = w; } }
            } else {
                bf16_t* base = ((u.pm * BM) >> 13) ? VTS1 : VTS0; const int ldt = SEQ, rowi = ((u.pm * BM) & (SEQ - 1)) + wr * 64 + fr, col0 = (u.pn - vt_lo) * BM + wc * 32 + 8 * fq;
#pragma unroll
                for (int ai = 0; ai < 2; ++ai)
#pragma unroll
                    for (int m = 0; m < 4; ++m) { const int row = rowi + ai * HALF + m * 16;
                        const float rs_ = ss_in ? rsqrtf(ss_in[row0 + ai * HALF + m * 16] * (1.f / DM) + EPS) : 1.f;
#pragma unroll
                        for (int bj = 0; bj < 2; ++bj)
#pragma unroll
                            for (int n = 0; n < 2; ++n)
#pragma unroll
                                for (int j = 0; j < 4; ++j) base[(size_t)(col0 + bj * HALF + 4 * n + j) * ldt + row] = (bf16_t)f2bf(acc[ai][bj][m][n][j] * rs_); }
            }
        } else {
            const int row0 = u.pm * BM + wr * 64 + fr, col0 = u.pn * BM + wc * 32 + 8 * fq;
#pragma unroll
            for (int ai = 0; ai < 2; ++ai)
#pragma unroll
                for (int m = 0; m < 4; ++m) { const int row = row0 + ai * HALF + m * 16;
#pragma unroll
                    for (int bj = 0; bj < 2; ++bj) { const int col = col0 + bj * HALF;
                        const u32x4 gv = *(const u32x4*)(gate + (size_t)row * LDU_E + col);
                        const f32x4 s0 = *(const f32x4*)(pscale + col), s1 = *(const f32x4*)(pscale + col + 4);
                        const f32x4 v0 = acc[ai][bj][m][0], v1 = acc[ai][bj][m][1];
                        u32x4 w;
                        w.x = pk2(v0[0] * s0[0] * silu(bflo(gv.x)), v0[1] * s0[1] * silu(bfhi(gv.x)));
                        w.y = pk2(v0[2] * s0[2] * silu(bflo(gv.y)), v0[3] * s0[3] * silu(bfhi(gv.y)));
                        w.z = pk2(v1[0] * s1[0] * silu(bflo(gv.z)), v1[1] * s1[1] * silu(bfhi(gv.z)));
                        w.w = pk2(v1[2] * s1[2] * silu(bflo(gv.w)), v1[3] * s1[3] * silu(bfhi(gv.w)));
                        *(u32x4*)(O + (size_t)row * ldc + col) = w; } }
        }
    }
    DI void softmax_store(f32x4 (&acc)[2][2][4][2], const Unit& u, int wr, int wc, int fr, int fq, LAS unsigned char* lds) const {
        LAS float* ex = (LAS float*)lds;
        const float scl2 = 0.06375871541229934f;
        const int rloc = wr * 64 + fr;
        float mloc[2][4];
#pragma unroll
        for (int ai = 0; ai < 2; ++ai)
#pragma unroll
            for (int m = 0; m < 4; ++m) { const int rl = rloc + ai * HALF + m * 16;
                const float rs_ = rsqrtf(ss_in[u.pm * BM + rl] * (1.f / DM) + EPS) * scl2;
                float mx = -3.0e38f;
#pragma unroll
                for (int bj = 0; bj < 2; ++bj)
#pragma unroll
                    for (int n = 0; n < 2; ++n)
#pragma unroll
                        for (int j = 0; j < 4; ++j) { const float v = acc[ai][bj][m][n][j] * rs_; acc[ai][bj][m][n][j] = v; mx = fmaxf(mx, v); }
                mx = fmaxf(mx, __shfl_xor(mx, 16)); mx = fmaxf(mx, __shfl_xor(mx, 32));
                float sm = 0.f;
#pragma unroll
                for (int bj = 0; bj < 2; ++bj)
#pragma unroll
                    for (int n = 0; n < 2; ++n)
#pragma unroll
                        for (int j = 0; j < 4; ++j) { const float e = __builtin_amdgcn_exp2f(acc[ai][bj][m][n][j] - mx); acc[ai][bj][m][n][j] = e; sm += e; }
                sm += __shfl_xor(sm, 16); sm += __shfl_xor(sm, 32);
                mloc[ai][m] = mx;
                if (fq == 0) { ex[(rl * 4 + wc) * 2] = mx; ex[(rl * 4 + wc) * 2 + 1] = sm; } }
        __syncthreads();
#pragma unroll
        for (int ai = 0; ai < 2; ++ai)
#pragma unroll
            for (int m = 0; m < 4; ++m) { const int rl = rloc + ai * HALF + m * 16;
                const f32x4 p0 = *(const LAS f32x4*)(ex + rl * 8), p1 = *(const LAS f32x4*)(ex + rl * 8 + 4);
                const float M = fmaxf(fmaxf(p0[0], p0[2]), fmaxf(p1[0], p1[2]));
                const float tot = p0[1] * __builtin_amdgcn_exp2f(p0[0] - M) + p0[3] * __builtin_amdgcn_exp2f(p0[2] - M) + p1[1] * __builtin_amdgcn_exp2f(p1[0] - M) + p1[3] * __builtin_amdgcn_exp2f(p1[2] - M);
                const float f = __builtin_amdgcn_exp2f(mloc[ai][m] - M) / tot;
                bf16_t* rowp = O + (size_t)(u.pm * BM + rl) * ldc + u.pn * BM + wc * 32 + 8 * fq;
#pragma unroll
                for (int bj = 0; bj < 2; ++bj) { const f32x4 v0 = acc[ai][bj][m][0] * f, v1 = acc[ai][bj][m][1] * f;
                    u32x4 w; w.x = cvt_pk_bf16(v0[0], v0[1]); w.y = cvt_pk_bf16(v0[2], v0[3]); w.z = cvt_pk_bf16(v1[0], v1[1]); w.w = cvt_pk_bf16(v1[2], v1[3]);
                    *(u32x4*)(rowp + bj * HALF) = w; } }
    }
};

DI void gemm_phase(LAS unsigned char* lds, const Sched& S, const Epi& Ep) {
    const int tid = opq_tid(), wid = __builtin_amdgcn_readfirstlane(tid >> 6), lane = tid & 63, wr = wid >> 2, wc = wid & 3, fr = lane & 15, fq = lane >> 4;
    const int K = S.K, nt = K / BK;
    unsigned voffA[2], voffB[2];
#pragma unroll
    for (int i = 0; i < 2; ++i) { int R, C; stage_rc(tid * 16 + i * 8192, R, C); const int Rb = Ep.PERM ? ((R & ~31) + perm32(R & 31)) : R;
        voffA[i] = (unsigned)(R * S.lda + C) * 2u; voffB[i] = (unsigned)(Rb * S.ldb + C) * 2u; }
    const size_t kstep = (size_t)(BK * 2);
    const size_t hstepA = (size_t)HALF * S.lda * 2, hstepB = (size_t)HALF * S.ldb * 2;
    const unsigned ldsw = (unsigned)wid * 1024u;
    const int aoff = lds_byte(wr * 64 + fr, fq * 8), boff = lds_byte(wc * 32 + fr, fq * 8);
#define PG8_SA(b, h) (((b) * 2 + (h)) * HTB)
#define PG8_SB(b, h) ((4 + (b) * 2 + (h)) * HTB)
#define PG8_STAGE(bufoff, gbase, voff) do { _Pragma("unroll") for (int _i = 0; _i < 2; ++_i) \
        __builtin_amdgcn_global_load_lds((const unsigned*)((const char*)(gbase) + (voff)[_i]), (LAS unsigned*)(lds + (bufoff) + ldsw + _i * 8192), 16, 0, 0); } while (0)
#define PG8_LDA(dst, b, h) do { _Pragma("unroll") for (int m = 0; m < 4; ++m) _Pragma("unroll") for (int k = 0; k < 2; ++k) dst[m][k] = *(const LAS bf16x8*)(lds + PG8_SA(b, h) + aoff + m * 2048 + k * 1024); } while (0)
#define PG8_LDB(dst, b, h) do { _Pragma("unroll") for (int n = 0; n < 2; ++n) _Pragma("unroll") for (int k = 0; k < 2; ++k) dst[n][k] = *(const LAS bf16x8*)(lds + PG8_SB(b, h) + boff + n * 2048 + k * 1024); } while (0)
#define PG8_MMA(ai, bj, At, Bt) do { __builtin_amdgcn_s_setprio(1); _Pragma("unroll") for (int m = 0; m < 4; ++m) _Pragma("unroll") for (int n = 0; n < 2; ++n) _Pragma("unroll") for (int k = 0; k < 2; ++k) \
        acc[ai][bj][m][n] = __builtin_amdgcn_mfma_f32_16x16x32_bf16(Bt[n][k], At[m][k], acc[ai][bj][m][n], 0, 0, 0); __builtin_amdgcn_s_setprio(0); } while (0)
#define PG8_WAIT_V(n) asm volatile("s_waitcnt vmcnt(" #n ")" ::: "memory")
#define PG8_WAIT_L(n) asm volatile("s_waitcnt lgkmcnt(" #n ")" ::: "memory")
#define PG8_BAR __builtin_amdgcn_s_barrier()
#define PG8_SCHED __builtin_amdgcn_sched_barrier(0)
    Unit cur, nxt; int ui = 0;
    if (!S.next(0, cur)) return;
    f32x4 acc[2][2][4][2];
#pragma unroll
    for (int a = 0; a < 2; ++a)
#pragma unroll
        for (int b = 0; b < 2; ++b)
#pragma unroll
            for (int m = 0; m < 4; ++m)
#pragma unroll
                for (int n = 0; n < 2; ++n) acc[a][b][m][n] = (f32x4){0.f, 0.f, 0.f, 0.f};
    bf16x8 At[4][2], B0[2][2], B1[2][2];
    const char* cA = S.pa(cur); const char* cB = S.pb(cur);
    PG8_STAGE(PG8_SB(0, 0), cB, voffB); PG8_STAGE(PG8_SB(0, 1), cB + hstepB, voffB); PG8_STAGE(PG8_SA(0, 0), cA, voffA); PG8_STAGE(PG8_SA(0, 1), cA + hstepA, voffA);
    if (wr == 1) PG8_BAR;
    PG8_WAIT_V(2); PG8_BAR;
    PG8_STAGE(PG8_SB(1, 0), cB + kstep, voffB); PG8_STAGE(PG8_SA(1, 0), cA + kstep, voffA); PG8_STAGE(PG8_SB(1, 1), cB + hstepB + kstep, voffB);
    PG8_WAIT_V(6); PG8_BAR;
    const bool align_epi = (Ep.MODE != 3);
    for (;;) {
        const bool has_next = S.next(ui + 1, nxt);
        const char* nA = has_next ? S.pa(nxt) : cA; const char* nB = has_next ? S.pb(nxt) : cB;
        for (int t = 0; t < nt; t += 2) {
            const bool last = (t == nt - 2);
            const char* a1 = cA + (size_t)(t + 1) * kstep;
            const char* a2 = last ? nA : cA + (size_t)(t + 2) * kstep; const char* b2 = last ? nB : cB + (size_t)(t + 2) * kstep;
            const char* a3 = a2 + kstep; const char* b3 = b2 + kstep;
            PG8_LDB(B0, 0, 0); PG8_LDB(B1, 0, 1); PG8_SCHED; PG8_LDA(At, 0, 0); PG8_STAGE(PG8_SA(1, 1), a1 + hstepA, voffA);
            PG8_WAIT_V(8); PG8_WAIT_L(0); PG8_BAR; PG8_MMA(0, 0, At, B0); PG8_MMA(0, 1, At, B1); PG8_BAR; PG8_SCHED;
            PG8_LDA(At, 0, 1); PG8_STAGE(PG8_SB(0, 0), b2, voffB); PG8_STAGE(PG8_SB(0, 1), b2 + hstepB, voffB); PG8_STAGE(PG8_SA(0, 0), a2, voffA);
            PG8_WAIT_V(8); PG8_WAIT_L(0); PG8_BAR; PG8_MMA(1, 0, At, B0); PG8_MMA(1, 1, At, B1); PG8_BAR; PG8_SCHED;
            PG8_LDB(B0, 1, 0); PG8_LDB(B1, 1, 1); PG8_SCHED; PG8_LDA(At, 1, 0); PG8_STAGE(PG8_SA(0, 1), a2 + hstepA, voffA);
            PG8_WAIT_V(8); PG8_WAIT_L(0); PG8_BAR; PG8_MMA(0, 0, At, B0); PG8_MMA(0, 1, At, B1); PG8_BAR; PG8_SCHED;
            PG8_LDA(At, 1, 1); PG8_STAGE(PG8_SB(1, 0), b3, voffB); PG8_STAGE(PG8_SB(1, 1), b3 + hstepB, voffB); PG8_STAGE(PG8_SA(1, 0), a3, voffA);
            PG8_WAIT_V(8); PG8_WAIT_L(0); PG8_BAR; PG8_MMA(1, 0, At, B0); PG8_MMA(1, 1, At, B1); PG8_BAR; PG8_SCHED;
        }
        if (align_epi) { if (wr == 0) PG8_BAR; }
        if (Ep.MODE != 3) Ep(acc, cur, wr, wc, fr, fq);
        if (!has_next) break;
#pragma unroll
        for (int a = 0; a < 2; ++a)
#pragma unroll
            for (int b = 0; b < 2; ++b)
#pragma unroll
                for (int m = 0; m < 4; ++m)
#pragma unroll
                    for (int n = 0; n < 2; ++n) acc[a][b][m][n] = (f32x4){0.f, 0.f, 0.f, 0.f};
        cur = nxt; cA = nA; cB = nB; ++ui;
        if (align_epi) { if (wr == 1) PG8_BAR; }
    }
    PG8_WAIT_V(0);
    if (!align_epi) { if (wr == 0) PG8_BAR; }
    PG8_BAR;
    if (Ep.MODE == 3) Ep.softmax_store(acc, cur, wr, wc, fr, fq, lds);
#undef PG8_SA
#undef PG8_SB
#undef PG8_STAGE
#undef PG8_LDA
#undef PG8_LDB
#undef PG8_MMA
#undef PG8_WAIT_V
#undef PG8_WAIT_L
#undef PG8_BAR
#undef PG8_SCHED
}
}

DI void transpose_item(const float* W, int K, int N, bf16_t* WT, LAS float* scr, int item, int lane, const float* gk = nullptr) {
    const int nblk = N / 32, kb = item / nblk, nb = item % nblk, k0 = 64 * kb, n0 = 32 * nb;
#pragma unroll 8
    for (int i = 0; i < 32; ++i) { const int kk = 2 * i + (lane >> 5); scr[kk * 33 + (lane & 31)] = W[(size_t)(k0 + kk) * N + n0 + (lane & 31)] * (gk ? gk[k0 + kk] : 1.f); }
    asm volatile("s_waitcnt lgkmcnt(0)" ::: "memory");
    const int c = lane & 7;
#pragma unroll
    for (int j = 0; j < 4; ++j) { const int n = (lane >> 3) + 8 * j; const LAS float* s = scr + (8 * c) * 33 + n;
        u32x4 o; o.x = pk2(s[0 * 33], s[1 * 33]); o.y = pk2(s[2 * 33], s[3 * 33]); o.z = pk2(s[4 * 33], s[5 * 33]); o.w = pk2(s[6 * 33], s[7 * 33]);
        *(u32x4*)(WT + (size_t)(n0 + n) * K + k0 + 8 * c) = o; }
    asm volatile("s_waitcnt lgkmcnt(0)" ::: "memory");
}
DI void rms_row_bf16(const float* xrow, const float* g, bf16_t* orow, int lane) {
    const f32x4* xr = (const f32x4*)xrow + lane; const f32x4* gr = (const f32x4*)g + lane;
    f32x4 v[8]; float s = 0.f;
#pragma unroll
    for (int j = 0; j < 8; ++j) { v[j] = xr[64 * j]; s += (v[j].x * v[j].x + v[j].y * v[j].y) + (v[j].z * v[j].z + v[j].w * v[j].w); }
    const float r = rsqrtf(wave_sum(s) * (1.f / DM) + EPS);
    u32x2* o8 = (u32x2*)orow + lane;
#pragma unroll
    for (int j = 0; j < 8; ++j) { const f32x4 gg = gr[64 * j]; u32x2 w; w.x = pk2(v[j].x * r * gg.x, v[j].y * r * gg.y); w.y = pk2(v[j].z * r * gg.z, v[j].w * r * gg.w); o8[64 * j] = w; }
}
DI void rms_rows_phase(const float* X, const float* g, bf16_t* O, int nrows) {
    const int tid_ = opq_tid(), lane = tid_ & 63, gw = opq_bid() * 8 + (tid_ >> 6), NGW = gridDim.x * 8;
    for (int m = gw; m < nrows; m += NGW) rms_row_bf16(X + (size_t)m * DM, g, O + (size_t)m * DM, lane);
}

DI void prologue(const Params& P, LAS unsigned char* lds) {
    const int tid_ = opq_tid(), lane = tid_ & 63, wave = tid_ >> 6, gw = opq_bid() * 8 + wave, NGW = gridDim.x * 8;
    LAS float* scr = (LAS float*)(lds + wave * 16384);
    unsigned char* ws = P.ws;
    constexpr int I_INE = 32 * 192, I_SQ = 32 * 64, I_INO = 32 * 256, I_KV = 32 * 128, I_POOL = 4 * 8;
    constexpr int NITEMS = I_INE + I_SQ + I_INO + I_SQ + 2 * I_KV + 2 * I_SQ + 4 * I_POOL;
    for (int it = gw; it < NITEMS; it += NGW) {
        int r = it;
        if (r < I_INE) { transpose_item(P.w_in_e, DM, 6144, (bf16_t*)(ws + WS_WINE), scr, r, lane); continue; } r -= I_INE;
        if (r < I_SQ) { transpose_item(P.w_out_e, DM, DM, (bf16_t*)(ws + WS_WOUTE), scr, r, lane); continue; } r -= I_SQ;
        if (r < I_INO) { transpose_item(P.w_in_o, DM, 8192, (bf16_t*)(ws + WS_WINO), scr, r, lane, P.g_mix + DM); continue; } r -= I_INO;
        if (r < I_SQ) { transpose_item(P.w_out_o, DM, DM, (bf16_t*)(ws + WS_WOUTO), scr, r, lane); continue; } r -= I_SQ;
        if (r < 2 * I_KV) { const int l = r / I_KV; transpose_item(P.wkv + (size_t)l * DM * 4096, DM, 4096, (bf16_t*)(ws + WS_WKV) + (size_t)l * DM * 4096, scr, r % I_KV, lane); continue; } r -= 2 * I_KV;
        if (r < 2 * I_SQ) { const int l = r / I_SQ; transpose_item(P.wo + (size_t)l * DM * DM, DM, DM, (bf16_t*)(ws + WS_WO) + (size_t)l * DM * DM, scr, r % I_SQ, lane); continue; } r -= 2 * I_SQ;
        { const int g = r / I_POOL; transpose_item(P.pool_w + (size_t)g * 65536, 256, 256, (bf16_t*)(ws + WS_POOLT) + (size_t)g * 65536, scr, r % I_POOL, lane); }
    }
    { const f32x4* src = (const f32x4*)P.wq; u32x2* dst = (u32x2*)(ws + WS_WQ);
      for (int i = opq_bid() * NTH + tid_; i < 2 * DM * DM / 4; i += gridDim.x * NTH) { const float gr = P.g_xa[i >> 9]; const f32x4 v = src[i] * gr; u32x2 w; w.x = pk2(v.x, v.y); w.y = pk2(v.z, v.w); dst[i] = w; } }
    { float* ss = (float*)(ws + WS_SS); for (int i = opq_bid() * NTH + tid_; i < 4 * MT; i += gridDim.x * NTH) ss[i] = 0.f; }
    rms_rows_phase(P.x, P.g_mix, (bf16_t*)(ws + WS_XN), MT);
    for (int m = gw; m < 1024; m += NGW) { const int l = m >> 9, row = m & 511;
        rms_row_bf16(P.mem + (size_t)row * DM, P.g_mem + l * DM, (bf16_t*)(ws + WS_HM) + (size_t)m * DM, lane); }
}

template <int WIN> DI void pool_mix_group(const bf16_t* U, bf16_t* MIX, int g, size_t first, size_t stride) {
    const size_t NTOT = (size_t)MT * 32;
    for (size_t p = first; p < NTOT; p += stride) {
        const int t = (int)(p >> 5), c0 = g * 256 + (int)(p & 31) * 8, pos = t & (SEQ - 1);
        const int n = (pos + 1 < WIN) ? pos + 1 : WIN;
        const bf16_t* src = U + (size_t)t * LDU_E + c0;
        u32x4 v[WIN];
#pragma unroll
        for (int r = 0; r < WIN; ++r) v[r] = *(const u32x4*)(src - (size_t)(r < n ? r : 0) * LDU_E);
        float a[8] = {0.f, 0.f, 0.f, 0.f, 0.f, 0.f, 0.f, 0.f};
#pragma unroll
        for (int r = 0; r < WIN; ++r) { const float m = (r < n) ? 1.f : 0.f;
            a[0] += m * bflo(v[r].x); a[1] += m * bfhi(v[r].x); a[2] += m * bflo(v[r].y); a[3] += m * bfhi(v[r].y); a[4] += m * bflo(v[r].z); a[5] += m * bfhi(v[r].z); a[6] += m * bflo(v[r].w); a[7] += m * bfhi(v[r].w); }
        const float inv = 1.f / (float)n;
        u32x4 w; w.x = pk2(a[0] * inv - bflo(v[0].x), a[1] * inv - bfhi(v[0].x)); w.y = pk2(a[2] * inv - bflo(v[0].y), a[3] * inv - bfhi(v[0].y));
        w.z = pk2(a[4] * inv - bflo(v[0].z), a[5] * inv - bfhi(v[0].z)); w.w = pk2(a[6] * inv - bflo(v[0].w), a[7] * inv - bfhi(v[0].w));
        *(u32x4*)(MIX + (size_t)t * 1024 + c0) = w;
    }
}
DI void pool_mix_phase(const Params& P) {
    const bf16_t* U = (const bf16_t*)(P.ws + WS_U); bf16_t* MIX = (bf16_t*)(P.ws + WS_MIX);
    const size_t first = (size_t)opq_bid() * NTH + opq_tid(), stride = (size_t)gridDim.x * NTH;
    pool_mix_group<2>(U, MIX, 0, first, stride); pool_mix_group<4>(U, MIX, 1, first, stride); pool_mix_group<8>(U, MIX, 2, first, stride); pool_mix_group<16>(U, MIX, 3, first, stride);
}

constexpr int HG_KT = 17408, HG_IT = 27648, HG_P = 37888, HG_ST = 40448, HG_O = 75264, HG_DEC = 92160;
DI void tr_write8(LAS unsigned char* base, int row_stride_b, int col_b, int r0, const u32x4& v) {
    *(LAS bf16_t*)(base + (r0 + 0) * row_stride_b + col_b) = (bf16_t)(v.x & 0xffffu); *(LAS bf16_t*)(base + (r0 + 1) * row_stride_b + col_b) = (bf16_t)(v.x >> 16);
    *(LAS bf16_t*)(base + (r0 + 2) * row_stride_b + col_b) = (bf16_t)(v.y & 0xffffu); *(LAS bf16_t*)(base + (r0 + 3) * row_stride_b + col_b) = (bf16_t)(v.y >> 16);
    *(LAS bf16_t*)(base + (r0 + 4) * row_stride_b + col_b) = (bf16_t)(v.z & 0xffffu); *(LAS bf16_t*)(base + (r0 + 5) * row_stride_b + col_b) = (bf16_t)(v.z >> 16);
    *(LAS bf16_t*)(base + (r0 + 6) * row_stride_b + col_b) = (bf16_t)(v.w & 0xffffu); *(LAS bf16_t*)(base + (r0 + 7) * row_stride_b + col_b) = (bf16_t)(v.w >> 16);
}

DI void hgrn_passA(const Params& P, LAS unsigned char* lds, int u, bool skip_gates) {
    const int tid = opq_tid(), lane = tid & 63, w = tid >> 6, g = lane >> 4, r16 = lane & 15;
    const int b = u >> 8, h = (u >> 5) & 7, sc = u & 31, tok0 = b * SEQ + sc * 256, chunk0 = tok0 >> 5;
    bf16_t* U = (bf16_t*)(P.ws + WS_U); float* DEC = (float*)(P.ws + WS_DEC);
#pragma unroll 1
    for (int r = skip_gates ? 2 : 0; r < 2; ++r) {
        const int task = tid + NTH * r, ch = task >> 7, d = task & 127, cc = h * 128 + d;
        const float lbv = 1.f / (1.f + __expf(P.lb[1024 + cc] - P.lb[cc]));
        bf16_t* pq = U + (size_t)(tok0 + ch * 32) * LDU_E + 2048 + cc; bf16_t* pf = pq + 1024;
        bf16_t qraw[32], fraw[32];
#pragma unroll
        for (int s = 0; s < 32; ++s) { qraw[s] = pq[(size_t)s * LDU_E]; fraw[s] = pf[(size_t)s * LDU_E]; }
        float bc = 0.f;
#pragma unroll
        for (int s = 0; s < 32; ++s) {
            const float qv = bf2f(qraw[s]), fl = bf2f(fraw[s]);
            const float ex = __expf(-fl), sg = __builtin_amdgcn_rcpf(1.f + ex), f = lbv + (1.f - lbv) * sg, kk = (1.f - lbv) * (ex * sg);
            bc += __logf(f);
            pq[(size_t)s * LDU_E] = (bf16_t)(pk2(qv * __expf(bc), 0.f) & 0xffffu); pf[(size_t)s * LDU_E] = (bf16_t)(pk2(kk * __expf(-bc), 0.f) & 0xffffu);
        }
        DEC[(size_t)(chunk0 + ch) * 1024 + cc] = __expf(bc);
    }
    __syncthreads();
    f32x4 acc[8];
#pragma unroll
    for (int dt = 0; dt < 8; ++dt) acc[dt] = (f32x4){0.f, 0.f, 0.f, 0.f};
    const int row = tid & 31, seg = tid >> 5;
    const bf16_t* src = U + (size_t)(tok0 + row) * LDU_E + h * 128 + seg * 8;
    u32x4 rk = *(const u32x4*)(src + 3072), ri = *(const u32x4*)(src + 4096);
    float rdec = (tid < 128) ? DEC[(size_t)chunk0 * 1024 + h * 128 + tid] : 1.f, dtot = 1.f;
    LAS unsigned char* KT = lds; LAS unsigned char* IT = lds + 10240; LAS float* dec = (LAS float*)(lds + 20480);
    for (int ch = 0; ch < 8; ++ch) {
        tr_write8(KT, 80, row * 2, seg * 8, rk); tr_write8(IT, 80, row * 2, seg * 8, ri);
        if (tid < 128) { dec[tid] = rdec; dtot *= rdec; }
        if (ch < 7) { const bf16_t* s2 = src + (size_t)(ch + 1) * 32 * LDU_E; rk = *(const u32x4*)(s2 + 3072); ri = *(const u32x4*)(s2 + 4096);
            if (tid < 128) rdec = DEC[(size_t)(chunk0 + ch + 1) * 1024 + h * 128 + tid]; }
        __syncthreads();
        const bf16x8 bi = *(const LAS bf16x8*)(IT + (16 * w + r16) * 80 + g * 16);
#pragma unroll
        for (int dt = 0; dt < 8; ++dt) {
            const bf16x8 a = *(const LAS bf16x8*)(KT + (16 * dt + r16) * 80 + g * 16);
            acc[dt] = mfma16(a, bi, acc[dt]);
            const f32x4 dv = *(const LAS f32x4*)(dec + 16 * dt + 4 * g);
            acc[dt] *= dv;
        }
        __syncthreads();
    }
    float* SE = (float*)(P.ws + WS_SE) + (size_t)u * 16384;
#pragma unroll
    for (int dt = 0; dt < 8; ++dt)
#pragma unroll
        for (int j = 0; j < 4; ++j) SE[(16 * dt + 4 * g + j) * 128 + 16 * w + r16] = acc[dt][j];
    if (tid < 128) ((float*)(P.ws + WS_DT))[u * 128 + tid] = dtot;
}

DI void hgrn_scan_phase(const Params& P) {
    float* SE = (float*)(P.ws + WS_SE); const float* DT = (const float*)(P.ws + WS_DT);
    const int NT = gridDim.x * NTH;
    for (int e = opq_bid() * NTH + opq_tid(); e < 16 * 16384; e += NT) {
        const int bh = e >> 14, idx = e & 16383, d = idx >> 7;
        float S = 0.f;
#pragma unroll 8
        for (int sc = 0; sc < 32; ++sc) { const int u = bh * 32 + sc; const float tmp = SE[(size_t)u * 16384 + idx]; SE[(size_t)u * 16384 + idx] = S; S = DT[u * 128 + d] * S + tmp; }
    }
}

DI void hgrn_passC(const Params& P, LAS unsigned char* lds, int u) {
    const int tid = opq_tid(), lane = tid & 63, w = tid >> 6, g = lane >> 4, r16 = lane & 15;
    const int b = u >> 8, h = (u >> 5) & 7, sc = u & 31, tok0 = b * SEQ + sc * 256, chunk0 = tok0 >> 5;
    const bf16_t* U = (const bf16_t*)(P.ws + WS_U); const float* DEC = (const float*)(P.ws + WS_DEC);
    bf16_t* Y = (bf16_t*)(P.ws + WS_XN);
    LAS unsigned char* Qs = lds; LAS unsigned char* Ks = lds + 8704; LAS unsigned char* KT = lds + HG_KT; LAS unsigned char* IT = lds + HG_IT;
    LAS unsigned char* Ps = lds + HG_P; LAS unsigned char* ST = lds + HG_ST; LAS float* Os = (LAS float*)(lds + HG_O); LAS float* dec = (LAS float*)(lds + HG_DEC);
    f32x4 acc[8];
    { const float* SEb = (const float*)(P.ws + WS_SE); const float* DTb = (const float*)(P.ws + WS_DT);
      f32x4 W[8];
#pragma unroll
      for (int dt = 0; dt < 8; ++dt) { acc[dt] = (f32x4){0.f, 0.f, 0.f, 0.f}; W[dt] = (f32x4){1.f, 1.f, 1.f, 1.f}; }
#pragma unroll 1
      for (int jj = sc - 1; jj >= 0; --jj) {
          const int uj = (u - sc) + jj; const float* SE = SEb + (size_t)uj * 16384; const float* DT = DTb + uj * 128;
          float wmax = 0.f;
#pragma unroll
          for (int dt = 0; dt < 8; ++dt) {
              const f32x4 dv = *(const f32x4*)(DT + 16 * dt + 4 * g);
#pragma unroll
              for (int j = 0; j < 4; ++j) acc[dt][j] += W[dt][j] * SE[(16 * dt + 4 * g + j) * 128 + 16 * w + r16];
              W[dt] *= dv; wmax = fmaxf(wmax, fmaxf(fmaxf(W[dt][0], W[dt][1]), fmaxf(W[dt][2], W[dt][3]))); }
          if (!__any(wmax > 0.f)) break;
      }
#pragma unroll
      for (int dt = 0; dt < 8; ++dt) {
          u32x2 pw; pw.x = pk2(acc[dt][0], acc[dt][1]); pw.y = pk2(acc[dt][2], acc[dt][3]);
          *(LAS u32x2*)(ST + (16 * w + r16) * 272 + (16 * dt + 4 * g) * 2) = pw; } }
    const int row = tid & 31, seg = tid >> 5;
    const bf16_t* src = U + (size_t)(tok0 + row) * LDU_E + h * 128 + seg * 8;
    u32x4 rq = *(const u32x4*)(src + 2048), rk = *(const u32x4*)(src + 3072), ri = *(const u32x4*)(src + 4096);
    float rdec = (tid < 128) ? DEC[(size_t)chunk0 * 1024 + h * 128 + tid] : 1.f;
    const int nc = tid >> 4, nv0 = (tid & 15) * 8;
    f32x4 ng0 = *(const f32x4*)(P.hg + h * 128 + nv0), ng1 = *(const f32x4*)(P.hg + h * 128 + nv0 + 4);
    for (int ch = 0; ch < 8; ++ch) {
        *(LAS u32x4*)(Qs + row * 272 + seg * 16) = rq; *(LAS u32x4*)(Ks + row * 272 + seg * 16) = rk;
        tr_write8(KT, 80, row * 2, seg * 8, rk); tr_write8(IT, 80, row * 2, seg * 8, ri);
        if (tid < 128) dec[tid] = rdec;
        if (ch < 7) { const bf16_t* s2 = src + (size_t)(ch + 1) * 32 * LDU_E; rq = *(const u32x4*)(s2 + 2048); rk = *(const u32x4*)(s2 + 3072); ri = *(const u32x4*)(s2 + 4096);
            if (tid < 128) rdec = DEC[(size_t)(chunk0 + ch + 1) * 1024 + h * 128 + tid]; }
        const u32x4 gv = *(const u32x4*)(U + (size_t)(tok0 + ch * 32 + nc) * LDU_E + 5120 + h * 128 + nv0);
        __syncthreads();
        f32x4 ao[2];
#pragma unroll
        for (int ci = 0; ci < 2; ++ci) { ao[ci] = (f32x4){0.f, 0.f, 0.f, 0.f};
#pragma unroll
            for (int ks = 0; ks < 4; ++ks) { const bf16x8 a = *(const LAS bf16x8*)(Qs + (16 * ci + r16) * 272 + (32 * ks + 8 * g) * 2);
                const bf16x8 bs = *(const LAS bf16x8*)(ST + (16 * w + r16) * 272 + (32 * ks + 8 * g) * 2);
                ao[ci] = mfma16(a, bs, ao[ci]); } }
        if (w < 4) { const int ci = w >> 1, si = w & 1; f32x4 s = (f32x4){0.f, 0.f, 0.f, 0.f};
#pragma unroll
            for (int ks = 0; ks < 4; ++ks) { const bf16x8 a = *(const LAS bf16x8*)(Qs + (16 * ci + r16) * 272 + (32 * ks + 8 * g) * 2);
                const bf16x8 bk = *(const LAS bf16x8*)(Ks + (16 * si + r16) * 272 + (32 * ks + 8 * g) * 2);
                s = mfma16(a, bk, s); }
#pragma unroll
            for (int j = 0; j < 4; ++j) { const int c = 16 * ci + 4 * g + j, sidx = 16 * si + r16;
                *(LAS bf16_t*)(Ps + c * 80 + sidx * 2) = (bf16_t)f2bf(sidx <= c ? s[j] : 0.f); } }
        __syncthreads();
        const bf16x8 bi = *(const LAS bf16x8*)(IT + (16 * w + r16) * 80 + g * 16);
#pragma unroll
        for (int ci = 0; ci < 2; ++ci) { const bf16x8 a = *(const LAS bf16x8*)(Ps + (16 * ci + r16) * 80 + g * 16);
            ao[ci] = mfma16(a, bi, ao[ci]);
#pragma unroll
            for (int j = 0; j < 4; ++j) Os[(16 * ci + 4 * g + j) * 132 + 16 * w + r16] = ao[ci][j]; }
#pragma unroll
        for (int dt = 0; dt < 8; ++dt) {
            const bf16x8 a = *(const LAS bf16x8*)(KT + (16 * dt + r16) * 80 + g * 16);
            acc[dt] = mfma16(a, bi, acc[dt]);
            const f32x4 dv = *(const LAS f32x4*)(dec + 16 * dt + 4 * g);
            acc[dt] *= dv;
            u32x2 pw; pw.x = pk2(acc[dt][0], acc[dt][1]); pw.y = pk2(acc[dt][2], acc[dt][3]);
            *(LAS u32x2*)(ST + (16 * w + r16) * 272 + (16 * dt + 4 * g) * 2) = pw;
        }
        __syncthreads();
        { const f32x4 o0 = *(const LAS f32x4*)(Os + nc * 132 + nv0), o1 = *(const LAS f32x4*)(Os + nc * 132 + nv0 + 4);
          float ss = (o0.x * o0.x + o0.y * o0.y) + (o0.z * o0.z + o0.w * o0.w) + (o1.x * o1.x + o1.y * o1.y) + (o1.z * o1.z + o1.w * o1.w);
          ss += __shfl_xor(ss, 1); ss += __shfl_xor(ss, 2); ss += __shfl_xor(ss, 4); ss += __shfl_xor(ss, 8);
          const float r = rsqrtf(ss * (1.f / 128.f) + EPS);
          u32x4 wv;
          wv.x = pk2(o0.x * r * ng0.x * silu(bflo(gv.x)), o0.y * r * ng0.y * silu(bfhi(gv.x)));
          wv.y = pk2(o0.z * r * ng0.z * silu(bflo(gv.y)), o0.w * r * ng0.w * silu(bfhi(gv.y)));
          wv.z = pk2(o1.x * r * ng1.x * silu(bflo(gv.z)), o1.y * r * ng1.y * silu(bfhi(gv.z)));
          wv.w = pk2(o1.z * r * ng1.z * silu(bflo(gv.w)), o1.w * r * ng1.w * silu(bfhi(gv.w)));
          *(u32x4*)(Y + (size_t)(tok0 + ch * 32 + nc) * DM + 1024 + h * 128 + nv0) = wv; }
    }
    __syncthreads();
}

constexpr size_t WS_VTS0 = 1 * MiB, WS_VTS1 = 470 * MiB;
constexpr int SB_VOFF = 52224, SB_FLAGS = 103424;
constexpr float SB_RDONE = 150.0403f;
template <bool MASK>
DI void sb_block(const LAS unsigned char* kb, const LAS unsigned char* vb, int koff, int s0, int tq, const bf16x8 (&qb)[4], f32x4 (&o)[8], float& R, int g, int r16) {
    const float scl2 = 0.12751743082459868f;
    f32x4 z[2];
#pragma unroll
    for (int kt = 0; kt < 2; ++kt) { z[kt] = (f32x4){0.f, 0.f, 0.f, 0.f};
#pragma unroll
        for (int ks = 0; ks < 4; ++ks) { const bf16x8 a = *(const LAS bf16x8*)(kb + (koff + 16 * kt + r16) * 272 + (32 * ks + 8 * g) * 2); z[kt] = mfma16(a, qb[ks], z[kt]); } }
    float tt[2][4], pin[2][4], TT[2];
#pragma unroll
    for (int kt = 0; kt < 2; ++kt) {
        float u[4];
#pragma unroll
        for (int j = 0; j < 4; ++j) { const float e = __builtin_amdgcn_exp2f(fminf(z[kt][j] * scl2, 60.f));
            tt[kt][j] = (!MASK || (s0 + 16 * kt + 4 * g + j < tq)) ? e : 0.f; u[j] = 1.f + tt[kt][j]; }
        const float p3 = u[3], p2 = u[2] * p3, p1 = u[1] * p2, p0 = u[0] * p1;
        const float o16 = __shfl_xor(p0, 16), a2 = p0 * o16, b2 = __shfl_xor(a2, 32);
        const float E = ((g & 1) == 0 ? o16 : 1.f) * (g < 2 ? b2 : 1.f);
        TT[kt] = a2 * b2; pin[kt][0] = p0 * E; pin[kt][1] = p1 * E; pin[kt][2] = p2 * E; pin[kt][3] = p3 * E;
    }
    const float cR = __builtin_amdgcn_exp2f(-R);
    float aw[2][4];
#pragma unroll
    for (int j = 0; j < 4; ++j) { aw[1][j] = tt[1][j] * __builtin_amdgcn_rcpf(pin[1][j]) * cR; aw[0][j] = tt[0][j] * __builtin_amdgcn_rcpf(pin[0][j] * TT[1]) * cR; }
    R += __builtin_amdgcn_logf(TT[0]) + __builtin_amdgcn_logf(TT[1]);
    u32x4 t; t.x = pk2(aw[0][0], aw[0][1]); t.y = pk2(aw[0][2], aw[0][3]); t.z = pk2(aw[1][0], aw[1][1]); t.w = pk2(aw[1][2], aw[1][3]); const bf16x8 bop = __builtin_bit_cast(bf16x8, t);
#pragma unroll
    for (int vt = 0; vt < 8; ++vt) { const LAS unsigned char* ap = vb + (16 * vt + r16) * 400 + (koff + 4 * g) * 2;
        const bf16x8 a = cat4(*(const LAS s16x4*)ap, *(const LAS s16x4*)(ap + 32)); o[vt] = mfma16(a, bop, o[vt]); }
}
DI void sb_phase(const Params& P, LAS unsigned char* lds) {
    const int tid = opq_tid(), lane = tid & 63, w = tid >> 6, g = lane >> 4, r16 = lane & 15;
    const int bid = opq_bid(), G = gridDim.x;
    const bf16_t* Uall = (const bf16_t*)(P.ws + WS_U); bf16_t* Yall = (bf16_t*)(P.ws + WS_XN);
    LAS int* flags = (LAS int*)(lds + SB_FLAGS);
    u32x4 rk[6], rv[6]; bf16x8 qn[4];
#define SB_LOAD(uu, rr) do { const int qt_ = (uu) & 63, bh_ = (uu) >> 6, b_ = bh_ >> 4, h_ = bh_ & 15, ks_ = qt_ * 128 + 128 - 192 * ((rr) + 1); \
        const bf16_t* Ub_ = Uall + (size_t)b_ * SEQ * LDU_O + 2048 + h_ * 128; const bf16_t* Vb_ = (const bf16_t*)(P.ws + (b_ ? WS_VTS1 : WS_VTS0)) + (size_t)h_ * 128 * SEQ; \
        _Pragma("unroll") for (int i = 0; i < 6; ++i) { const int p = tid + NTH * i; int kg = ks_ + (p >> 4); kg = kg < 0 ? 0 : kg; rk[i] = *(const u32x4*)(Ub_ + (size_t)kg * LDU_O + (p & 15) * 8); \
            const int v_ = p / 24, sg_ = p - 24 * v_; int kc = ks_ + sg_ * 8; kc = kc < 0 ? 0 : kc; rv[i] = *(const u32x4*)(Vb_ + (size_t)v_ * SEQ + kc); } } while (0)
#define SB_LOADQ(uu) do { const int qt_ = (uu) & 63, bh_ = (uu) >> 6, b_ = bh_ >> 4, h_ = bh_ & 15; const bf16_t* qp_ = Uall + ((size_t)b_ * SEQ + qt_ * 128 + 16 * w + r16) * LDU_O + h_ * 128 + 8 * g; \
        _Pragma("unroll") for (int ks = 0; ks < 4; ++ks) qn[ks] = *(const bf16x8*)(qp_ + 32 * ks); } while (0)
    int u = bid, r = 0;
    if (u >= 2048) return;
    SB_LOAD(u, 0); SB_LOADQ(u);
    bf16x8 qb[4]; f32x4 o[8]; float R = 0.f;
#pragma unroll
    for (int ks = 0; ks < 4; ++ks) qb[ks] = qn[ks];
#pragma unroll
    for (int vt = 0; vt < 8; ++vt) o[vt] = (f32x4){0.f, 0.f, 0.f, 0.f};
    for (;;) {
        const int qt = u & 63, bh = u >> 6, b = bh >> 4, h = bh & 15, t0 = qt * 128, tq = t0 + 16 * w + r16, twmax = t0 + 16 * w + 15;
        const int kstart = t0 + 128 - 192 * (r + 1);
#pragma unroll
        for (int i = 0; i < 6; ++i) { const int p = tid + NTH * i; *(LAS u32x4*)(lds + (p >> 4) * 272 + (p & 15) * 16) = rk[i];
            const int v_ = p / 24, sg_ = p - 24 * v_; *(LAS u32x4*)(lds + SB_VOFF + v_ * 400 + sg_ * 16) = rv[i]; }
        const bool spec_same = (r == 0) && (kstart > 0);
        const int nu = spec_same ? u : u + G, nr = spec_same ? 1 : 0;
        if (nu < 2048) { SB_LOAD(nu, nr); if (!spec_same) SB_LOADQ(nu); }
        __syncthreads();
#pragma unroll 1
        for (int hb = 5; hb >= 0; --hb) { const int s0 = kstart + 32 * hb;
            if (s0 < 0) break;
            if (s0 >= twmax) continue;
            if (__all(R > SB_RDONE)) break;
            if (s0 + 32 > twmax - 15) sb_block<true>(lds, lds + SB_VOFF, 32 * hb, s0, tq, qb, o, R, g, r16);
            else sb_block<false>(lds, lds + SB_VOFF, 32 * hb, s0, tq, qb, o, R, g, r16); }
        if (lane == 0) flags[w] = __all(R > SB_RDONE) ? 1 : 0;
        __syncthreads();
        if (spec_same) { r = 1; continue; }
        int alld = 1;
#pragma unroll
        for (int i = 0; i < 8; ++i) alld &= flags[i];
        if (alld || kstart <= 0) {
            { const bf16_t* gp = Uall + ((size_t)b * SEQ + tq) * LDU_O + 6144 + h * 128 + 4 * g; bf16_t* yp = (bf16_t*)Uall + ((size_t)b * SEQ + tq) * LDU_O + h * 128 + 4 * g;
#pragma unroll
              for (int vt = 0; vt < 8; ++vt) { const u32x2 gv = *(const u32x2*)(gp + 16 * vt);
                  u32x2 wv; wv.x = pk2(o[vt][0] * silu(bflo(gv.x)), o[vt][1] * silu(bfhi(gv.x))); wv.y = pk2(o[vt][2] * silu(bflo(gv.y)), o[vt][3] * silu(bfhi(gv.y)));
                  *(u32x2*)(yp + 16 * vt) = wv; } }
            u = nu; r = 0; R = 0.f;
            if (u >= 2048) break;
#pragma unroll
            for (int ks = 0; ks < 4; ++ks) qb[ks] = qn[ks];
#pragma unroll
            for (int vt = 0; vt < 8; ++vt) o[vt] = (f32x4){0.f, 0.f, 0.f, 0.f};
        } else {
            r = r + 1; SB_LOAD(u, r);
        }
    }
#undef SB_LOAD
#undef SB_LOADQ
    __syncthreads();
}

DI void final_norm_phase(const Params& P) {
    const int tid_ = opq_tid(), lane = tid_ & 63, gw = opq_bid() * 8 + (tid_ >> 6), NGW = gridDim.x * 8;
    const bf16_t* X = (const bf16_t*)(P.ws + WS_XN); const float* SS = (const float*)(P.ws + WS_SS) + 3 * MT;
    for (int mrow = gw; mrow < MT; mrow += NGW) {
        const u32x4* xr = (const u32x4*)(X + (size_t)mrow * DM) + lane; f32x4* orow = (f32x4*)(P.out + (size_t)mrow * DM); const f32x4* gr = (const f32x4*)P.g_fin;
        const float r = rsqrtf(SS[mrow] * (1.f / DM) + EPS);
        u32x4 v[4];
#pragma unroll
        for (int j = 0; j < 4; ++j) v[j] = xr[64 * j];
#pragma unroll
        for (int j = 0; j < 4; ++j) { const int c4 = (64 * j + lane) * 2; const f32x4 g0 = gr[c4], g1 = gr[c4 + 1];
            orow[c4] = (f32x4){bflo(v[j].x) * r * g0.x, bfhi(v[j].x) * r * g0.y, bflo(v[j].y) * r * g0.z, bfhi(v[j].y) * r * g0.w};
            orow[c4 + 1] = (f32x4){bflo(v[j].z) * r * g1.x, bfhi(v[j].z) * r * g1.y, bflo(v[j].w) * r * g1.z, bfhi(v[j].w) * r * g1.w}; }
    }
}

#define XB_TMO      128
#define XB_XCNT(j)  (256  + 64 * (j))
#define XB_XSUB(j)  (1280 + 64 * (j))
#define XB_XGEN(j)  (2304 + 64 * (j))
#define XB_TOP      3328
#define XB_TOPGEN   3392
#define XCD_BAR_WORDS 3456
#define XB_SPIN_CAP (1u << 18)
DI unsigned xb_ld(unsigned* p)              { return __hip_atomic_load(p, __ATOMIC_RELAXED, __HIP_MEMORY_SCOPE_AGENT); }
DI unsigned xb_add(unsigned* p, unsigned v) { return __hip_atomic_fetch_add(p, v, __ATOMIC_RELAXED, __HIP_MEMORY_SCOPE_AGENT); }
DI unsigned xb_xcc_id() { return (unsigned)__builtin_amdgcn_s_getreg((3 << 11) | 20) & 0xFu; }
#define XB_SPIN(cond, bar) do { unsigned _sp = 0; while (cond) { __builtin_amdgcn_s_sleep(1); \
    if ((++_sp & 255u) == 0u) { if (xb_ld(&(bar)[XB_TMO])) break; if (_sp > XB_SPIN_CAP) { atomicAdd(&(bar)[XB_TMO], 1u); break; } } } } while (0)
struct XcdBarrier { unsigned* bar; unsigned x; volatile LAS unsigned* st; };
DI XcdBarrier xcd_barrier_post(unsigned* bar, volatile LAS unsigned* st) {
    XcdBarrier b; b.bar = bar; b.x = xb_xcc_id(); b.st = st;
    if (threadIdx.x == 0) (void)xb_add(&bar[XB_XCNT(b.x)], 1u);
    return b;
}
DI void xcd_barrier_complete(unsigned* bar, unsigned x, unsigned& nloc, unsigned& nx) {
    const unsigned G = gridDim.x * gridDim.y * gridDim.z;
    unsigned sum, cnt, mine, sp = 0u;
    for (;;) {
        sum = 0u; cnt = 0u; mine = 0u;
#pragma unroll
        for (unsigned j = 0; j < 16; ++j) { const unsigned c = xb_ld(&bar[XB_XCNT(j)]); sum += c; cnt += (c > 0u) ? 1u : 0u; mine = (j == x) ? c : mine; }
        if (sum == G) break;
        __builtin_amdgcn_s_sleep(1);
        if ((++sp & 255u) == 0u) { if (xb_ld(&bar[XB_TMO])) break; if (sp > XB_SPIN_CAP) { atomicAdd(&bar[XB_TMO], 1u); break; } }
    }
    nloc = mine > 0u ? mine : 1u; nx = cnt > 0u ? cnt : 1u;
}
DI void xcd_barrier(const XcdBarrier& b) {
    asm volatile("s_waitcnt vmcnt(0)" ::: "memory");
    __syncthreads();
    if (threadIdx.x == 0) {
        unsigned* bar = b.bar;
        __builtin_amdgcn_s_waitcnt(0);
        unsigned nloc = b.st[0], nx = b.st[1];
        if (nloc == 0u) { xcd_barrier_complete(bar, b.x, nloc, nx); b.st[0] = nloc; b.st[1] = nx; }
        const unsigned old = xb_add(&bar[XB_XSUB(b.x)], 1u);
        const unsigned gen = old / nloc;
        if (old + 1u == (gen + 1u) * nloc) {
            __builtin_amdgcn_fence(__ATOMIC_RELEASE, "agent");
            asm volatile("s_waitcnt vmcnt(0)" ::: "memory");
            const unsigned og = xb_add(&bar[XB_TOP], 1u);
            const unsigned tg = og / nx;
            if (og + 1u == (tg + 1u) * nx) xb_add(&bar[XB_TOPGEN], 1u);
            else XB_SPIN(xb_ld(&bar[XB_TOPGEN]) == tg, bar);
            __builtin_amdgcn_fence(__ATOMIC_ACQUIRE, "agent");
            xb_add(&bar[XB_XGEN(b.x)], 1u);
            asm volatile("s_waitcnt vmcnt(0)" ::: "memory");
        } else {
            XB_SPIN(xb_ld(&bar[XB_XGEN(b.x)]) == gen, bar);
            __builtin_amdgcn_fence(__ATOMIC_ACQUIRE, "agent");
            asm volatile("s_waitcnt vmcnt(0)" ::: "memory");
        }
    }
    __syncthreads();
}

__global__ void __launch_bounds__(NTH, 2) fwd_megakernel(Params P0) {
    extern __shared__ __attribute__((aligned(16))) unsigned char lds_raw[];
    LAS unsigned char* lds = (LAS unsigned char*)lds_raw;
    cg::grid_group grid = cg::this_grid();
    if (threadIdx.x < 4) ((LAS unsigned*)(lds + LDS_BARST))[threadIdx.x] = 0u;
    __syncthreads();
    const XcdBarrier xbar = xcd_barrier_post((unsigned*)P0.ws, (volatile LAS unsigned*)(lds + LDS_BARST));
    const int G = gridDim.x, nph = P0.nph;

    if (nph < 0) grid.sync();
    constexpr unsigned GEMM_MASK = (1u << 1) | (1u << 2) | (1u << 4) | (1u << 5) | (1u << 7) | (1u << 9) | (1u << 11) | (1u << 13) | (1u << 15) | (1u << 17);
#pragma unroll 1
    for (int ph = 0; ph < nph; ++ph) {
        Params P = P0; { unsigned char* w_ = P0.ws; asm volatile("" : "+s"(w_)); P.ws = w_; }
        unsigned char* ws = P.ws; const int bid = opq_bid();
        bf16_t* XN = (bf16_t*)(ws + WS_XN); bf16_t* Ub = (bf16_t*)(ws + WS_U);
        if (ph == 3 || ph == 6 || ph == 8 || ph == 10 || ph == 14 || ph == 16) continue;
        const int nrep = ((PROBE_MASK >> ph) & 1u) ? 2 : 1;
        for (int rep = 0; rep < nrep; ++rep) {
        if (rep) __syncthreads();
        if (ph == 0) prologue(P, lds);
        else if (ph == 2) { pool_mix_phase(P); for (int u = bid; u < 512; u += G) hgrn_passA(P, lds, u, rep > 0); }
        else if (ph == 3) { if (rep == 0) hgrn_scan_phase(P); }
        else if (ph == 4) { for (int u = bid; u < 512; u += G) hgrn_passC(P, lds, u); }
        else if (ph == 12) sb_phase(P, lds);
        else if (ph == 18) final_norm_phase(P);
        if ((GEMM_MASK >> ph) & 1u) {
            pg8::Sched S; pg8::Epi E{};
            const int layer = (ph >= 12) ? 1 : 0;
            bf16_t* XN2 = (bf16_t*)(ws + WS_U + 64 * MiB);
            bf16_t* BtS = (bf16_t*)(ws + (layer ? 89 : 1) * MiB); bf16_t* BtN = (bf16_t*)(ws + (layer ? 97 : 9) * MiB);
            const bf16_t* A = (ph == 9 || ph == 13 || ph == 17) ? Ub : ((ph == 7) ? XN2 : XN); const bf16_t* Bt; int N = DM, K = DM, lda = DM, ldb = DM, apn = 0; long bbs = 0;
            E.MODE = (ph == 5 || ph == 9 || ph == 13 || ph == 17) ? 1 : (ph == 4 ? 2 : ((ph == 7 || ph == 15) ? 3 : 0)); E.PERM = true;
            E.O = Ub; E.ldc = DM; E.KX = (bf16_t*)(ws + WS_KX); E.VX = (bf16_t*)(ws + WS_VT); E.BtS = BtS; E.BtN = BtN; E.BtS1 = (bf16_t*)(ws + 89 * MiB); E.BtN1 = (bf16_t*)(ws + 97 * MiB); E.res = (ph == 5) ? P.x : nullptr; E.resb = (ph == 9) ? XN2 : ((ph == 13 || ph == 17) ? XN : nullptr); E.out = P.out; E.xr_out = (ph == 5) ? XN2 : XN; E.gate = Ub + 1024; E.pscale = P.pool_s;
            { float* SS = (float*)(ws + WS_SS); const int si = (ph == 5 || ph == 7) ? 0 : ((ph == 9 || ph == 11) ? 1 : ((ph == 17) ? 3 : 2));
              const bool prod = (ph == 5 || ph == 9 || ph == 13 || ph == 17), cons = (ph == 7 || ph == 11 || ph == 15);
              E.ss_out = prod ? SS + si * MT : nullptr; E.ss_in = cons ? SS + si * MT : nullptr; }
            E.vt_lo = (ph == 11) ? 16 : (1 << 20); E.VTS0 = (bf16_t*)(ws + WS_VTS0); E.VTS1 = (bf16_t*)(ws + WS_VTS1);
            if (ph == 1) { Bt = (const bf16_t*)(ws + WS_WINE); N = 6144; E.ldc = LDU_E; }
            else if (ph == 2) { Bt = nullptr; K = 512; }
            else if (ph == 4) { A = (const bf16_t*)(ws + WS_MIX); Bt = (const bf16_t*)(ws + WS_POOLT); N = 1024; K = 256; lda = 1024; ldb = 256; apn = 512; E.O = XN; }
            else if (ph == 5) Bt = (const bf16_t*)(ws + WS_WOUTE);
            else if (ph == 7 || ph == 15) { Bt = BtS; N = 1024; bbs = 1024L * DM; E.ldc = 1024; }
            else if (ph == 9 || ph == 17) { Bt = BtN; K = 1024; lda = 1024; ldb = 1024; bbs = 2048L * 1024; }
            else if (ph == 11) { Bt = (const bf16_t*)(ws + WS_WINO); N = 8192; E.ldc = LDU_O; }
            else { Bt = (const bf16_t*)(ws + WS_WOUTO); lda = LDU_O; }
            S.init(A, Bt, MT, N, K, lda, ldb, apn); S.b_batch_stride = bbs;
            if (ph == 1) { S.n_extra = 64; S.A2 = (const bf16_t*)(ws + WS_HM); S.B2 = (const bf16_t*)(ws + WS_WKV); }
            if (ph == 2) { S.pre = 1; S.KXl = (const bf16_t*)(ws + WS_KX); S.VXl = (const bf16_t*)(ws + WS_VT); S.WQp = (const bf16_t*)(ws + WS_WQ); S.WOt = (const bf16_t*)(ws + WS_WO); }
            pg8::gemm_phase(lds, S, E);
        }
        }
        if (ph + 1 < nph) xcd_barrier(xbar);
#ifdef PROBE_SYNCS
        if (ph == 5) { for (int i = 0; i < PROBE_SYNCS; ++i) xcd_barrier(xbar); }
#endif
    }
}

extern "C" void kernel_launch(void* const* d_in, const int* in_sizes, int n_in, void* d_out, int out_size, void* d_ws, size_t ws_size, hipStream_t stream) {
    static int grid = 0;
    if (grid == 0) {
        if (n_in != 17 || out_size != MT * DM || ws_size < WS_END) { fprintf(stderr, "kernel_launch: unexpected shapes (n_in %d out %d ws %zu)\n", n_in, out_size, ws_size); grid = -1; return; }
        int dev = 0, cus = 0, per_cu = 0;
        (void)hipGetDevice(&dev);
        (void)hipDeviceGetAttribute(&cus, hipDeviceAttributeMultiprocessorCount, dev);
        if (hipFuncSetAttribute((const void*)fwd_megakernel, hipFuncAttributeMaxDynamicSharedMemorySize, LDS_BYTES) != hipSuccess) { fprintf(stderr, "kernel_launch: hipFuncSetAttribute failed\n"); grid = -1; return; }
        if (hipOccupancyMaxActiveBlocksPerMultiprocessor(&per_cu, (const void*)fwd_megakernel, NTH, LDS_BYTES) != hipSuccess || per_cu < 1) { fprintf(stderr, "kernel_launch: occupancy query failed (%d)\n", per_cu); per_cu = 1; }
        (void)hipGetLastError();
        grid = cus * per_cu;
        fprintf(stderr, "kernel_launch: grid %d (cus %d x %d)\n", grid, cus, per_cu);
    }
    if (grid < 0) return;
    Params p{};
    const float** pp = (const float**)&p;
    for (int i = 0; i < 17; ++i) pp[i] = (const float*)d_in[i];
    p.out = (float*)d_out; p.ws = (unsigned char*)d_ws; p.nph = 19;
    if (hipMemsetAsync(d_ws, 0, 16384, stream) != hipSuccess) { fprintf(stderr, "kernel_launch: memset failed\n"); return; }
    void* args[] = {&p};
    hipError_t e = hipLaunchCooperativeKernel((const void*)fwd_megakernel, dim3(grid), dim3(NTH), args, LDS_BYTES, stream);
    if (e != hipSuccess) fprintf(stderr, "cooperative launch failed: %s (grid %d)\n", hipGetErrorString(e), grid);
}
```

```cpp
#include <hip/hip_runtime.h>
#include <hip/hip_cooperative_groups.h>
#include <cstdio>
namespace cg = cooperative_groups;

#define DI __device__ __forceinline__
#define LAS __attribute__((address_space(3)))
typedef unsigned short bf16_t;
typedef short bf16x8 __attribute__((ext_vector_type(8)));
typedef short s16x4 __attribute__((ext_vector_type(4)));
typedef float f32x4 __attribute__((ext_vector_type(4)));
typedef unsigned u32x4 __attribute__((ext_vector_type(4)));
typedef unsigned u32x2 __attribute__((ext_vector_type(2)));

constexpr int DM = 2048, SEQ = 8192, NBATCH = 2, MT = NBATCH * SEQ, MEMLEN = 256;
constexpr int NTH = 512, LDS_BYTES = 147456, LDS_BARST = 147440;
#ifndef PROBE_MASK
#define PROBE_MASK 0u
#endif
constexpr float EPS = 1e-6f;
constexpr int LDU_E = 6144, LDU_O = 8192;

constexpr size_t MiB = 1u << 20;
constexpr size_t WS_WINE = 1 * MiB, WS_WOUTE = 25 * MiB, WS_WINO = 33 * MiB, WS_WOUTO = 65 * MiB, WS_WQ = 73 * MiB, WS_WKV = 89 * MiB, WS_WO = 121 * MiB, WS_POOLT = 137 * MiB;
constexpr size_t WS_HM = 138 * MiB, WS_KX = 142 * MiB, WS_VT = 146 * MiB, WS_XN = 150 * MiB, WS_U = 214 * MiB;
constexpr size_t WS_MIX = 406 * MiB;
constexpr size_t WS_SE = 470 * MiB;
constexpr size_t WS_DT = 502 * MiB;
constexpr size_t WS_DEC = 503 * MiB;
constexpr size_t WS_SS = 502 * MiB + 512 * 1024;
constexpr size_t WS_END = 512 * MiB;

struct Params {
    const float *x, *mem, *g_mix, *g_xa, *g_mem, *g_fin, *w_in_e, *pool_w, *pool_s, *lb, *hg, *w_out_e, *w_in_o, *w_out_o, *wq, *wkv, *wo;
    float* out; unsigned char* ws; int nph, pad;
};

DI unsigned f2bf(float f) { unsigned u = __builtin_bit_cast(unsigned, f); return (u + 0x7fffu + ((u >> 16) & 1u)) >> 16; }
typedef __bf16 bf16x2_t __attribute__((ext_vector_type(2)));
typedef float f32x2_t __attribute__((ext_vector_type(2)));
DI unsigned pk2(float lo, float hi) { f32x2_t f = {lo, hi}; bf16x2_t v = __builtin_convertvector(f, bf16x2_t); return __builtin_bit_cast(unsigned, v); }
DI float bf2f(unsigned v) { return __builtin_bit_cast(float, v << 16); }
DI float bflo(unsigned w) { return __builtin_bit_cast(float, w << 16); }
DI float bfhi(unsigned w) { return __builtin_bit_cast(float, w & 0xffff0000u); }
DI float wave_sum(float v) {
#pragma unroll
    for (int o = 1; o < 64; o <<= 1) v += __shfl_xor(v, o);
    return v;
}
DI int opq_tid() { int t = threadIdx.x; asm volatile("" : "+v"(t)); return t; }
DI int opq_bid() { int b = blockIdx.x; asm volatile("" : "+s"(b)); return b; }
DI float silu(float v) { return v / (1.f + __expf(-v)); }
DI f32x4 mfma16(bf16x8 a, bf16x8 b, f32x4 c) { return __builtin_amdgcn_mfma_f32_16x16x32_bf16(a, b, c, 0, 0, 0); }
DI bf16x8 cat4(s16x4 lo, s16x4 hi) { return __builtin_shufflevector(lo, hi, 0, 1, 2, 3, 4, 5, 6, 7); }

namespace pg8 {
constexpr int BM = 256, BK = 64, HALF = 128, HTB = HALF * BK * 2, STAGE_BYTES = 8 * HTB, NXCD = 8, WGM = 8;
DI int lds_byte(int r, int c) { const int st = (r >> 4) * 2 + (c >> 5), rr = r & 15, cc = c & 31, ob = rr * 64 + cc * 2; return st * 1024 + (ob ^ (((ob >> 9) & 1) << 5)); }
DI void stage_rc(int b, int& R, int& C) { const int st = b / 1024, sb = b % 1024, swz = sb ^ (((sb >> 9) & 1) << 5); R = (st >> 1) * 16 + swz / 64; C = (st & 1) * 32 + (swz % 64) / 2; }
DI int perm32(int rho) { const int n = rho >> 4, i = rho & 15; return 8 * (i >> 2) + 4 * n + (i & 3); }
DI unsigned cvt_pk_bf16(float lo, float hi) { unsigned r; asm volatile("v_cvt_pk_bf16_f32 %0, %1, %2" : "=v"(r) : "v"(lo), "v"(hi)); return r; }

struct Unit { int pm, pn, gi; };
struct Sched {
    const bf16_t* A; const bf16_t* Bt; int lda, ldb, a_pn_bytes, K; long b_batch_stride;
    int nM, nN, nwg, G, c;
    int n_extra; const bf16_t* A2; const bf16_t* B2;
    int pre; const bf16_t* KXl; const bf16_t* VXl; const bf16_t* WQp; const bf16_t* WOt;
    DI void init(const bf16_t* A_, const bf16_t* Bt_, int M, int N, int K_, int lda_, int ldb_, int a_pn_bytes_) {
        A = A_; Bt = Bt_; lda = lda_; ldb = ldb_; a_pn_bytes = a_pn_bytes_; K = K_; b_batch_stride = 0; nM = M / BM; nN = N / BM; nwg = nM * nN; G = gridDim.x; c = opq_bid(); n_extra = 0; A2 = nullptr; B2 = nullptr;
        pre = 0; KXl = nullptr; VXl = nullptr; WQp = nullptr; WOt = nullptr;
    }
    DI bool next(int i, Unit& u) const {
        const long L = (long)i * G + c;
        const long total = pre ? 256 : (long)(nwg + n_extra);
        if (L >= total) return false;
        const bool ex = (!pre) && (L >= nwg); const int e = (int)(L - nwg), Li = (int)L;
        int wgid = (ex || pre) ? 0 : Li; { const int q = nwg / NXCD, r = nwg % NXCD, xcd = wgid % NXCD, off = wgid / NXCD; wgid = (xcd < r ? xcd * (q + 1) : r * (q + 1) + (xcd - r) * q) + off; }
        const int nig = WGM * nN, gid = wgid / nig, fm = gid * WGM, gsz = (nM - fm) < WGM ? (nM - fm) : WGM;
        const int pm0 = fm + ((wgid % nig) % gsz), pn0 = (wgid % nig) / gsz;
        u.pm = pre ? (Li & 7) : (ex ? ((e & 31) >> 4) : pm0);
        u.pn = pre ? ((Li >> 3) & 7) : (ex ? (e & 15) : pn0);
        u.gi = pre ? 3 + ((Li >> 6) & 1) + 2 * (Li >> 7) : (ex ? 1 + (e >> 5) : 0);
        return true;
    }
    DI const char* pa(const Unit& u) const {
        const int b = u.pn >> 2, h = u.pn & 3; const bf16_t* p;
        if (u.gi == 0) p = A + (size_t)u.pm * BM * (size_t)lda + (size_t)u.pn * (a_pn_bytes >> 1);
        else if (u.gi <= 2) p = A2 + ((size_t)(u.gi - 1) * 512 + (size_t)u.pm * BM) * (size_t)lda;
        else if (((u.gi - 3) & 1) == 0) p = KXl + (size_t)((u.gi - 3) >> 1) * 512 * DM + (size_t)(b * 256) * DM + h * 512;
        else p = WOt + (size_t)((u.gi - 3) >> 1) * DM * DM + (size_t)(u.pm * 256) * DM + h * 512;
        return (const char*)p;
    }
    DI const char* pb(const Unit& u) const {
        const int b = u.pn >> 2, h = u.pn & 3; const bf16_t* p;
        if (u.gi == 0) p = Bt + (size_t)(u.pm >> 5) * (size_t)b_batch_stride + (size_t)u.pn * BM * (size_t)ldb;
        else if (u.gi <= 2) p = B2 + ((size_t)(u.gi - 1) * 4096 + (size_t)u.pn * BM) * (size_t)ldb;
        else if (((u.gi - 3) & 1) == 0) p = WQp + (size_t)((u.gi - 3) >> 1) * DM * DM + (size_t)(u.pm * 256) * DM + h * 512;
        else p = VXl + (size_t)((u.gi - 3) >> 1) * 512 * DM + (size_t)(b * 256) * DM + h * 512;
        return (const char*)p;
    }
};

struct Epi {
    int MODE; bool PERM;
    bf16_t* O; int ldc;
    bf16_t* KX; bf16_t* VX;
    bf16_t* BtS1; bf16_t* BtN1; bf16_t* BtS; bf16_t* BtN;
    int vt_lo; bf16_t* VTS0; bf16_t* VTS1;
    const float* res; const bf16_t* resb; float* out; bf16_t* xr_out; float* ss_out;
    const float* ss_in;
    const bf16_t* gate; const float* pscale;
    DI void operator()(const f32x4 (&acc)[2][2][4][2], const Unit& u, int wr, int wc, int fr, int fq) const {
        if (MODE == 1) {
            const int row0 = u.pm * BM + wr * 64 + fr, col0 = u.pn * BM + wc * 32 + 8 * fq;
#pragma unroll
            for (int ai = 0; ai < 2; ++ai) {
                f32x4 rr[4][2][2];
                if (resb) {
                    u32x4 rb[4][2];
#pragma unroll
                    for (int m = 0; m < 4; ++m)
#pragma unroll
                        for (int bj = 0; bj < 2; ++bj) rb[m][bj] = *(const u32x4*)(resb + (size_t)(row0 + ai * HALF + m * 16) * DM + col0 + bj * HALF);
#pragma unroll
                    for (int m = 0; m < 4; ++m)
#pragma unroll
                        for (int bj = 0; bj < 2; ++bj) { rr[m][bj][0] = (f32x4){bflo(rb[m][bj].x), bfhi(rb[m][bj].x), bflo(rb[m][bj].y), bfhi(rb[m][bj].y)};
                            rr[m][bj][1] = (f32x4){bflo(rb[m][bj].z), bfhi(rb[m][bj].z), bflo(rb[m][bj].w), bfhi(rb[m][bj].w)}; }
                } else {
#pragma unroll
                    for (int m = 0; m < 4; ++m)
#pragma unroll
                        for (int bj = 0; bj < 2; ++bj)
#pragma unroll
                            for (int n = 0; n < 2; ++n) rr[m][bj][n] = *(const f32x4*)(res + (size_t)(row0 + ai * HALF + m * 16) * DM + col0 + bj * HALF + 4 * n);
                }
#pragma unroll
                for (int m = 0; m < 4; ++m) { const int row = row0 + ai * HALF + m * 16; const size_t ro = (size_t)row * DM + col0; float ssq = 0.f;
#pragma unroll
                    for (int bj = 0; bj < 2; ++bj) { const f32x4 v0 = acc[ai][bj][m][0] + rr[m][bj][0], v1 = acc[ai][bj][m][1] + rr[m][bj][1];
                        if (xr_out) { u32x4 w; w.x = pk2(v0[0], v0[1]); w.y = pk2(v0[2], v0[3]); w.z = pk2(v1[0], v1[1]); w.w = pk2(v1[2], v1[3]); *(u32x4*)(xr_out + ro + bj * HALF) = w; }
                        else { *(f32x4*)(out + ro + bj * HALF) = v0; *(f32x4*)(out + ro + bj * HALF + 4) = v1; }
                        ssq += ((v0[0] * v0[0] + v0[1] * v0[1]) + (v0[2] * v0[2] + v0[3] * v0[3])) + ((v1[0] * v1[0] + v1[1] * v1[1]) + (v1[2] * v1[2] + v1[3] * v1[3])); }
                    if (ss_out) { ssq += __shfl_xor(ssq, 16); ssq += __shfl_xor(ssq, 32); if (fq == 0) atomicAdd(ss_out + row, ssq); } }
            }
        } else if (MODE == 0) {
            const int row0 = u.pm * BM + wr * 64 + fr;
            const bool sbv = (u.gi == 0) && ((unsigned)(u.pn - vt_lo) < 8u);
            if (!sbv) {
                const int bb = u.pn >> 2, hh = u.pn & 3;
                bf16_t* base; int ld, rowb, colb;
                if (u.gi == 0) { base = O; ld = ldc; rowb = u.pm * BM; colb = u.pn * BM; }
                else if (u.gi <= 2) { base = ((u.pn >= 8) ? VX : KX) + (size_t)(u.gi - 1) * 512 * DM; ld = DM; rowb = u.pm * BM; colb = (u.pn & 7) * BM; }
                else if (((u.gi - 3) & 1) == 0) { base = ((u.gi >= 5) ? BtS1 : BtS) + (size_t)(bb * 1024 + hh * 256) * DM; ld = DM; rowb = 0; colb = u.pm * BM; }
                else { base = ((u.gi >= 5) ? BtN1 : BtN) + (size_t)(bb * 2048 + u.pm * 256) * 1024; ld = 1024; rowb = 0; colb = hh * 256; }
                const int rloc = wr * 64 + fr, col0 = colb + wc * 32 + 8 * fq;
#pragma unroll
                for (int ai = 0; ai < 2; ++ai)
#pragma unroll
                    for (int m = 0; m < 4; ++m) { bf16_t* rowp = base + (size_t)(rowb + rloc + ai * HALF + m * 16) * ld + col0;
                        const float rs_ = ss_in ? rsqrtf(ss_in[row0 + ai * HALF + m * 16] * (1.f / DM) + EPS) : 1.f;
#pragma unroll
                        for (int bj = 0; bj < 2; ++bj) { const f32x4 v0 = acc[ai][bj][m][0] * rs_, v1 = acc[ai][bj][m][1] * rs_;
                            u32x4 w; w.x = cvt_pk_bf16(v0[0], v0[1]); w.y = cvt_pk_bf16(v0[2], v0[3]); w.z = cvt_pk_bf16(v1[0], v1[1]); w.w = cvt_pk_bf16(v1[2], v1[3]);
                            *(u32x4*)(rowp + bj * HALF) = w; } }
            } else {
                bf16_t* base = ((u.pm * BM) >> 13) ? VTS1 : VTS0; const int ldt = SEQ, rowi = ((u.pm * BM) & (SEQ - 1)) + wr * 64 + fr, col0 = (u.pn - vt_lo) * BM + wc * 32 + 8 * fq;
#pragma unroll
                for (int ai = 0; ai < 2; ++ai)
#pragma unroll
                    for (int m = 0; m < 4; ++m) { const int row = rowi + ai * HALF + m * 16;
                        const float rs_ = ss_in ? rsqrtf(ss_in[row0 + ai * HALF + m * 16] * (1.f / DM) + EPS) : 1.f;
#pragma unroll
                        for (int bj = 0; bj < 2; ++bj)
#pragma unroll
                            for (int n = 0; n < 2; ++n)
#pragma unroll
                                for (int j = 0; j < 4; ++j) base[(size_t)(col0 + bj * HALF + 4 * n + j) * ldt + row] = (bf16_t)f2bf(acc[ai][bj][m][n][j] * rs_); }
            }
        } else {
            const int row0 = u.pm * BM + wr * 64 + fr, col0 = u.pn * BM + wc * 32 + 8 * fq;
#pragma unroll
            for (int ai = 0; ai < 2; ++ai)
#pragma unroll
                for (int m = 0; m < 4; ++m) { const int row = row0 + ai * HALF + m * 16;
#pragma unroll
                    for (int bj = 0; bj < 2; ++bj) { const int col = col0 + bj * HALF;
                        const u32x4 gv = *(const u32x4*)(gate + (size_t)row * LDU_E + col);
                        const f32x4 s0 = *(const f32x4*)(pscale + col), s1 = *(const f32x4*)(pscale + col + 4);
                        const f32x4 v0 = acc[ai][bj][m][0], v1 = acc[ai][bj][m][1];
                        u32x4 w;
                        w.x = pk2(v0[0] * s0[0] * silu(bflo(gv.x)), v0[1] * s0[1] * silu(bfhi(gv.x)));
                        w.y = pk2(v0[2] * s0[2] * silu(bflo(gv.y)), v0[3] * s0[3] * silu(bfhi(gv.y)));
                        w.z = pk2(v1[0] * s1[0] * silu(bflo(gv.z)), v1[1] * s1[1] * silu(bfhi(gv.z)));
                        w.w = pk2(v1[2] * s1[2] * silu(bflo(gv.w)), v1[3] * s1[3] * silu(bfhi(gv.w)));
                        *(u32x4*)(O + (size_t)row * ldc + col) = w; } }
        }
    }
    DI void softmax_store(f32x4 (&acc)[2][2][4][2], const Unit& u, int wr, int wc, int fr, int fq, LAS unsigned char* lds) const {
        LAS float* ex = (LAS float*)lds;
        const float scl2 = 0.06375871541229934f;
        const int rloc = wr * 64 + fr;
        float mloc[2][4];
#pragma unroll
        for (int ai = 0; ai < 2; ++ai)
#pragma unroll
            for (int m = 0; m < 4; ++m) { const int rl = rloc + ai * HALF + m * 16;
                const float rs_ = rsqrtf(ss_in[u.pm * BM + rl] * (1.f / DM) + EPS) * scl2;
                float mx = -3.0e38f;
#pragma unroll
                for (int bj = 0; bj < 2; ++bj)
#pragma unroll
                    for (int n = 0; n < 2; ++n)
#pragma unroll
                        for (int j = 0; j < 4; ++j) { const float v = acc[ai][bj][m][n][j] * rs_; acc[ai][bj][m][n][j] = v; mx = fmaxf(mx, v); }
                mx = fmaxf(mx, __shfl_xor(mx, 16)); mx = fmaxf(mx, __shfl_xor(mx, 32));
                float sm = 0.f;
#pragma unroll
                for (int bj = 0; bj < 2; ++bj)
#pragma unroll
                    for (int n = 0; n < 2; ++n)
#pragma unroll
                        for (int j = 0; j < 4; ++j) { const float e = __builtin_amdgcn_exp2f(acc[ai][bj][m][n][j] - mx); acc[ai][bj][m][n][j] = e; sm += e; }
                sm += __shfl_xor(sm, 16); sm += __shfl_xor(sm, 32);
                mloc[ai][m] = mx;
                if (fq == 0) { ex[(rl * 4 + wc) * 2] = mx; ex[(rl * 4 + wc) * 2 + 1] = sm; } }
        __syncthreads();
#pragma unroll
        for (int ai = 0; ai < 2; ++ai)
#pragma unroll
            for (int m = 0; m < 4; ++m) { const int rl = rloc + ai * HALF + m * 16;
                const f32x4 p0 = *(const LAS f32x4*)(ex + rl * 8), p1 = *(const LAS f32x4*)(ex + rl * 8 + 4);
                const float M = fmaxf(fmaxf(p0[0], p0[2]), fmaxf(p1[0], p1[2]));
                const float tot = p0[1] * __builtin_amdgcn_exp2f(p0[0] - M) + p0[3] * __builtin_amdgcn_exp2f(p0[2] - M) + p1[1] * __builtin_amdgcn_exp2f(p1[0] - M) + p1[3] * __builtin_amdgcn_exp2f(p1[2] - M);
                const float f = __builtin_amdgcn_exp2f(mloc[ai][m] - M) / tot;
                bf16_t* rowp = O + (size_t)(u.pm * BM + rl) * ldc + u.pn * BM + wc * 32 + 8 * fq;
#pragma unroll
                for (int bj = 0; bj < 2; ++bj) { const f32x4 v0 = acc[ai][bj][m][0] * f, v1 = acc[ai][bj][m][1] * f;
                    u32x4 w; w.x = cvt_pk_bf16(v0[0], v0[1]); w.y = cvt_pk_bf16(v0[2], v0[3]); w.z = cvt_pk_bf16(v1[0], v1[1]); w.w = cvt_pk_bf16(v1[2], v1[3]);
                    *(u32x4*)(rowp + bj * HALF) = w; } }
    }
};

DI void gemm_phase(LAS unsigned char* lds, const Sched& S, const Epi& Ep) {
    const int tid = opq_tid(), wid = __builtin_amdgcn_readfirstlane(tid >> 6), lane = tid & 63, wr = wid >> 2, wc = wid & 3, fr = lane & 15, fq = lane >> 4;
    const int K = S.K, nt = K / BK;
    unsigned voffA[2], voffB[2];
#pragma unroll
    for (int i = 0; i < 2; ++i) { int R, C; stage_rc(tid * 16 + i * 8192, R, C); const int Rb = Ep.PERM ? ((R & ~31) + perm32(R & 31)) : R;
        voffA[i] = (unsigned)(R * S.lda + C) * 2u; voffB[i] = (unsigned)(Rb * S.ldb + C) * 2u; }
    const size_t kstep = (size_t)(BK * 2);
    const size_t hstepA = (size_t)HALF * S.lda * 2, hstepB = (size_t)HALF * S.ldb * 2;
    const unsigned ldsw = (unsigned)wid * 1024u;
    const int aoff = lds_byte(wr * 64 + fr, fq * 8), boff = lds_byte(wc * 32 + fr, fq * 8);
#define PG8_SA(b, h) (((b) * 2 + (h)) * HTB)
#define PG8_SB(b, h) ((4 + (b) * 2 + (h)) * HTB)
#define PG8_STAGE(bufoff, gbase, voff) do { _Pragma("unroll") for (int _i = 0; _i < 2; ++_i) \
        __builtin_amdgcn_global_load_lds((const unsigned*)((const char*)(gbase) + (voff)[_i]), (LAS unsigned*)(lds + (bufoff) + ldsw + _i * 8192), 16, 0, 0); } while (0)
#define PG8_LDA(dst, b, h) do { _Pragma("unroll") for (int m = 0; m < 4; ++m) _Pragma("unroll") for (int k = 0; k < 2; ++k) dst[m][k] = *(const LAS bf16x8*)(lds + PG8_SA(b, h) + aoff + m * 2048 + k * 1024); } while (0)
#define PG8_LDB(dst, b, h) do { _Pragma("unroll") for (int n = 0; n < 2; ++n) _Pragma("unroll") for (int k = 0; k < 2; ++k) dst[n][k] = *(const LAS bf16x8*)(lds + PG8_SB(b, h) + boff + n * 2048 + k * 1024); } while (0)
#define PG8_MMA(ai, bj, At, Bt) do { __builtin_amdgcn_s_setprio(1); _Pragma("unroll") for (int m = 0; m < 4; ++m) _Pragma("unroll") for (int n = 0; n < 2; ++n) _Pragma("unroll") for (int k = 0; k < 2; ++k) \
        acc[ai][bj][m][n] = __builtin_amdgcn_mfma_f32_16x16x32_bf16(Bt[n][k], At[m][k], acc[ai][bj][m][n], 0, 0, 0); __builtin_amdgcn_s_setprio(0); } while (0)
#define PG8_WAIT_V(n) asm volatile("s_waitcnt vmcnt(" #n ")" ::: "memory")
#define PG8_WAIT_L(n) asm volatile("s_waitcnt lgkmcnt(" #n ")" ::: "memory")
#define PG8_BAR __builtin_amdgcn_s_barrier()
#define PG8_SCHED __builtin_amdgcn_sched_barrier(0)
    Unit cur, nxt; int ui = 0;
    if (!S.next(0, cur)) return;
    f32x4 acc[2][2][4][2];
#pragma unroll
    for (int a = 0; a < 2; ++a)
#pragma unroll
        for (int b = 0; b < 2; ++b)
#pragma unroll
            for (int m = 0; m < 4; ++m)
#pragma unroll
                for (int n = 0; n < 2; ++n) acc[a][b][m][n] = (f32x4){0.f, 0.f, 0.f, 0.f};
    bf16x8 At[4][2], B0[2][2], B1[2][2];
    const char* cA = S.pa(cur); const char* cB = S.pb(cur);
    PG8_STAGE(PG8_SB(0, 0), cB, voffB); PG8_STAGE(PG8_SB(0, 1), cB + hstepB, voffB); PG8_STAGE(PG8_SA(0, 0), cA, voffA); PG8_STAGE(PG8_SA(0, 1), cA + hstepA, voffA);
    if (wr == 1) PG8_BAR;
    PG8_WAIT_V(2); PG8_BAR;
    PG8_STAGE(PG8_SB(1, 0), cB + kstep, voffB); PG8_STAGE(PG8_SA(1, 0), cA + kstep, voffA); PG8_STAGE(PG8_SB(1, 1), cB + hstepB + kstep, voffB);
    PG8_WAIT_V(6); PG8_BAR;
    const bool align_epi = (Ep.MODE != 3);
    for (;;) {
        const bool has_next = S.next(ui + 1, nxt);
        const char* nA = has_next ? S.pa(nxt) : cA; const char* nB = has_next ? S.pb(nxt) : cB;
        for (int t = 0; t < nt; t += 2) {
            const bool last = (t == nt - 2);
            const char* a1 = cA + (size_t)(t + 1) * kstep;
            const char* a2 = last ? nA : cA + (size_t)(t + 2) * kstep; const char* b2 = last ? nB : cB + (size_t)(t + 2) * kstep;
            const char* a3 = a2 + kstep; const char* b3 = b2 + kstep;
            PG8_LDB(B0, 0, 0); PG8_LDB(B1, 0, 1); PG8_SCHED; PG8_LDA(At, 0, 0); PG8_STAGE(PG8_SA(1, 1), a1 + hstepA, voffA);
            PG8_WAIT_V(8); PG8_WAIT_L(0); PG8_BAR; PG8_MMA(0, 0, At, B0); PG8_MMA(0, 1, At, B1); PG8_BAR; PG8_SCHED;
            PG8_LDA(At, 0, 1); PG8_STAGE(PG8_SB(0, 0), b2, voffB); PG8_STAGE(PG8_SB(0, 1), b2 + hstepB, voffB); PG8_STAGE(PG8_SA(0, 0), a2, voffA);
            PG8_WAIT_V(8); PG8_WAIT_L(0); PG8_BAR; PG8_MMA(1, 0, At, B0); PG8_MMA(1, 1, At, B1); PG8_BAR; PG8_SCHED;
            PG8_LDB(B0, 1, 0); PG8_LDB(B1, 1, 1); PG8_SCHED; PG8_LDA(At, 1, 0); PG8_STAGE(PG8_SA(0, 1), a2 + hstepA, voffA);
            PG8_WAIT_V(8); PG8_WAIT_L(0); PG8_BAR; PG8_MMA(0, 0, At, B0); PG8_MMA(0, 1, At, B1); PG8_BAR; PG8_SCHED;
            PG8_LDA(At, 1, 1); PG8_STAGE(PG8_SB(1, 0), b3, voffB); PG8_STAGE(PG8_SB(1, 1), b3 + hstepB, voffB); PG8_STAGE(PG8_SA(1, 0), a3, voffA);
            PG8_WAIT_V(8); PG8_WAIT_L(0); PG8_BAR; PG8_MMA(1, 0, At, B0); PG8_MMA(1, 1, At, B1); PG8_BAR; PG8_SCHED;
        }
        if (align_epi) { if (wr == 0) PG8_BAR; }
        if (Ep.MODE != 3) Ep(acc, cur, wr, wc, fr, fq);
        if (!has_next) break;
#pragma unroll
        for (int a = 0; a < 2; ++a)
#pragma unroll
            for (int b = 0; b < 2; ++b)
#pragma unroll
                for (int m = 0; m < 4; ++m)
#pragma unroll
                    for (int n = 0; n < 2; ++n) acc[a][b][m][n] = (f32x4){0.f, 0.f, 0.f, 0.f};
        cur = nxt; cA = nA; cB = nB; ++ui;
        if (align_epi) { if (wr == 1) PG8_BAR; }
    }
    PG8_WAIT_V(0);
    if (!align_epi) { if (wr == 0) PG8_BAR; }
    PG8_BAR;
    if (Ep.MODE == 3) Ep.softmax_store(acc, cur, wr, wc, fr, fq, lds);
#undef PG8_SA
#undef PG8_SB
#undef PG8_STAGE
#undef PG8_LDA
#undef PG8_LDB
#undef PG8_MMA
#undef PG8_WAIT_V
#undef PG8_WAIT_L
#undef PG8_BAR
#undef PG8_SCHED
}
}

DI void transpose_item(const float* W, int K, int N, bf16_t* WT, LAS float* scr, int item, int lane, const float* gk = nullptr) {
    const int nblk = N / 32, kb = item / nblk, nb = item % nblk, k0 = 64 * kb, n0 = 32 * nb;
#pragma unroll 8
    for (int i = 0; i < 32; ++i) { const int kk = 2 * i + (lane >> 5); scr[kk * 33 + (lane & 31)] = __builtin_nontemporal_load(W + (size_t)(k0 + kk) * N + n0 + (lane & 31)) * (gk ? gk[k0 + kk] : 1.f); }
    asm volatile("s_waitcnt lgkmcnt(0)" ::: "memory");
    const int c = lane & 7;
#pragma unroll
    for (int j = 0; j < 4; ++j) { const int n = (lane >> 3) + 8 * j; const LAS float* s = scr + (8 * c) * 33 + n;
        u32x4 o; o.x = pk2(s[0 * 33], s[1 * 33]); o.y = pk2(s[2 * 33], s[3 * 33]); o.z = pk2(s[4 * 33], s[5 * 33]); o.w = pk2(s[6 * 33], s[7 * 33]);
        *(u32x4*)(WT + (size_t)(n0 + n) * K + k0 + 8 * c) = o; }
    asm volatile("s_waitcnt lgkmcnt(0)" ::: "memory");
}
DI void rms_row_bf16(const float* xrow, const float* g, bf16_t* orow, int lane) {
    const f32x4* xr = (const f32x4*)xrow + lane; const f32x4* gr = (const f32x4*)g + lane;
    f32x4 v[8]; float s = 0.f;
#pragma unroll
    for (int j = 0; j < 8; ++j) { v[j] = __builtin_nontemporal_load(xr + 64 * j); s += (v[j].x * v[j].x + v[j].y * v[j].y) + (v[j].z * v[j].z + v[j].w * v[j].w); }
    const float r = rsqrtf(wave_sum(s) * (1.f / DM) + EPS);
    u32x2* o8 = (u32x2*)orow + lane;
#pragma unroll
    for (int j = 0; j < 8; ++j) { const f32x4 gg = gr[64 * j]; u32x2 w; w.x = pk2(v[j].x * r * gg.x, v[j].y * r * gg.y); w.y = pk2(v[j].z * r * gg.z, v[j].w * r * gg.w); o8[64 * j] = w; }
}
DI void rms_rows_phase(const float* X, const float* g, bf16_t* O, int nrows) {
    const int tid_ = opq_tid(), lane = tid_ & 63, gw = opq_bid() * 8 + (tid_ >> 6), NGW = gridDim.x * 8;
    for (int m = gw; m < nrows; m += NGW) rms_row_bf16(X + (size_t)m * DM, g, O + (size_t)m * DM, lane);
}

DI void prologue(const Params& P, LAS unsigned char* lds) {
    const int tid_ = opq_tid(), lane = tid_ & 63, wave = tid_ >> 6, gw = opq_bid() * 8 + wave, NGW = gridDim.x * 8;
    LAS float* scr = (LAS float*)(lds + wave * 16384);
    unsigned char* ws = P.ws;
    constexpr int I_INE = 32 * 192, I_SQ = 32 * 64, I_INO = 32 * 256, I_KV = 32 * 128, I_POOL = 4 * 8;
    constexpr int NITEMS = I_INE + I_SQ + I_INO + I_SQ + 2 * I_KV + 2 * I_SQ + 4 * I_POOL;
    for (int it = gw; it < NITEMS; it += NGW) {
        int r = it;
        if (r < I_INE) { transpose_item(P.w_in_e, DM, 6144, (bf16_t*)(ws + WS_WINE), scr, r, lane); continue; } r -= I_INE;
        if (r < I_SQ) { transpose_item(P.w_out_e, DM, DM, (bf16_t*)(ws + WS_WOUTE), scr, r, lane); continue; } r -= I_SQ;
        if (r < I_INO) { transpose_item(P.w_in_o, DM, 8192, (bf16_t*)(ws + WS_WINO), scr, r, lane, P.g_mix + DM); continue; } r -= I_INO;
        if (r < I_SQ) { transpose_item(P.w_out_o, DM, DM, (bf16_t*)(ws + WS_WOUTO), scr, r, lane); continue; } r -= I_SQ;
        if (r < 2 * I_KV) { const int l = r / I_KV; transpose_item(P.wkv + (size_t)l * DM * 4096, DM, 4096, (bf16_t*)(ws + WS_WKV) + (size_t)l * DM * 4096, scr, r % I_KV, lane); continue; } r -= 2 * I_KV;
        if (r < 2 * I_SQ) { const int l = r / I_SQ; transpose_item(P.wo + (size_t)l * DM * DM, DM, DM, (bf16_t*)(ws + WS_WO) + (size_t)l * DM * DM, scr, r % I_SQ, lane); continue; } r -= 2 * I_SQ;
        { const int g = r / I_POOL; transpose_item(P.pool_w + (size_t)g * 65536, 256, 256, (bf16_t*)(ws + WS_POOLT) + (size_t)g * 65536, scr, r % I_POOL, lane); }
    }
    { const f32x4* src = (const f32x4*)P.wq; u32x2* dst = (u32x2*)(ws + WS_WQ);
      for (int i = opq_bid() * NTH + tid_; i < 2 * DM * DM / 4; i += gridDim.x * NTH) { const float gr = P.g_xa[i >> 9]; const f32x4 v = __builtin_nontemporal_load(src + i) * gr; u32x2 w; w.x = pk2(v.x, v.y); w.y = pk2(v.z, v.w); dst[i] = w; } }
    { float* ss = (float*)(ws + WS_SS); for (int i = opq_bid() * NTH + tid_; i < 4 * MT; i += gridDim.x * NTH) ss[i] = 0.f; }
    rms_rows_phase(P.x, P.g_mix, (bf16_t*)(ws + WS_XN), MT);
    for (int m = gw; m < 1024; m += NGW) { const int l = m >> 9, row = m & 511;
        rms_row_bf16(P.mem + (size_t)row * DM, P.g_mem + l * DM, (bf16_t*)(ws + WS_HM) + (size_t)m * DM, lane); }
}

template <int WIN> DI void pool_mix_group(const bf16_t* U, bf16_t* MIX, int g, size_t first, size_t stride) {
    const size_t NTOT = (size_t)MT * 32;
    for (size_t p = first; p < NTOT; p += stride) {
        const int t = (int)(p >> 5), c0 = g * 256 + (int)(p & 31) * 8, pos = t & (SEQ - 1);
        const int n = (pos + 1 < WIN) ? pos + 1 : WIN;
        const bf16_t* src = U + (size_t)t * LDU_E + c0;
        u32x4 v[WIN];
#pragma unroll
        for (int r = 0; r < WIN; ++r) v[r] = *(const u32x4*)(src - (size_t)(r < n ? r : 0) * LDU_E);
        float a[8] = {0.f, 0.f, 0.f, 0.f, 0.f, 0.f, 0.f, 0.f};
#pragma unroll
        for (int r = 0; r < WIN; ++r) { const float m = (r < n) ? 1.f : 0.f;
            a[0] += m * bflo(v[r].x); a[1] += m * bfhi(v[r].x); a[2] += m * bflo(v[r].y); a[3] += m * bfhi(v[r].y); a[4] += m * bflo(v[r].z); a[5] += m * bfhi(v[r].z); a[6] += m * bflo(v[r].w); a[7] += m * bfhi(v[r].w); }
        const float inv = 1.f / (float)n;
        u32x4 w; w.x = pk2(a[0] * inv - bflo(v[0].x), a[1] * inv - bfhi(v[0].x)); w.y = pk2(a[2] * inv - bflo(v[0].y), a[3] * inv - bfhi(v[0].y));
        w.z = pk2(a[4] * inv - bflo(v[0].z), a[5] * inv - bfhi(v[0].z)); w.w = pk2(a[6] * inv - bflo(v[0].w), a[7] * inv - bfhi(v[0].w));
        *(u32x4*)(MIX + (size_t)t * 1024 + c0) = w;
    }
}
DI void pool_mix_phase(const Params& P) {
    const bf16_t* U = (const bf16_t*)(P.ws + WS_U); bf16_t* MIX = (bf16_t*)(P.ws + WS_MIX);
    const size_t first = (size_t)opq_bid() * NTH + opq_tid(), stride = (size_t)gridDim.x * NTH;
    pool_mix_group<2>(U, MIX, 0, first, stride); pool_mix_group<4>(U, MIX, 1, first, stride); pool_mix_group<8>(U, MIX, 2, first, stride); pool_mix_group<16>(U, MIX, 3, first, stride);
}

constexpr int HG_KT = 17408, HG_IT = 27648, HG_P = 37888, HG_ST = 40448, HG_O = 75264, HG_DEC = 92160;
DI void tr_write8(LAS unsigned char* base, int row_stride_b, int col_b, int r0, const u32x4& v) {
    *(LAS bf16_t*)(base + (r0 + 0) * row_stride_b + col_b) = (bf16_t)(v.x & 0xffffu); *(LAS bf16_t*)(base + (r0 + 1) * row_stride_b + col_b) = (bf16_t)(v.x >> 16);
    *(LAS bf16_t*)(base + (r0 + 2) * row_stride_b + col_b) = (bf16_t)(v.y & 0xffffu); *(LAS bf16_t*)(base + (r0 + 3) * row_stride_b + col_b) = (bf16_t)(v.y >> 16);
    *(LAS bf16_t*)(base + (r0 + 4) * row_stride_b + col_b) = (bf16_t)(v.z & 0xffffu); *(LAS bf16_t*)(base + (r0 + 5) * row_stride_b + col_b) = (bf16_t)(v.z >> 16);
    *(LAS bf16_t*)(base + (r0 + 6) * row_stride_b + col_b) = (bf16_t)(v.w & 0xffffu); *(LAS bf16_t*)(base + (r0 + 7) * row_stride_b + col_b) = (bf16_t)(v.w >> 16);
}

DI void hgrn_passA(const Params& P, LAS unsigned char* lds, int u, bool skip_gates) {
    const int tid = opq_tid(), lane = tid & 63, w = tid >> 6, g = lane >> 4, r16 = lane & 15;
    const int b = u >> 8, h = (u >> 5) & 7, sc = u & 31, tok0 = b * SEQ + sc * 256, chunk0 = tok0 >> 5;
    bf16_t* U = (bf16_t*)(P.ws + WS_U); float* DEC = (float*)(P.ws + WS_DEC);
#pragma unroll 1
    for (int r = skip_gates ? 2 : 0; r < 2; ++r) {
        const int task = tid + NTH * r, ch = task >> 7, d = task & 127, cc = h * 128 + d;
        const float lbv = 1.f / (1.f + __expf(P.lb[1024 + cc] - P.lb[cc]));
        bf16_t* pq = U + (size_t)(tok0 + ch * 32) * LDU_E + 2048 + cc; bf16_t* pf = pq + 1024;
        bf16_t qraw[32], fraw[32];
#pragma unroll
        for (int s = 0; s < 32; ++s) { qraw[s] = pq[(size_t)s * LDU_E]; fraw[s] = pf[(size_t)s * LDU_E]; }
        float bc = 0.f;
#pragma unroll
        for (int s = 0; s < 32; ++s) {
            const float qv = bf2f(qraw[s]), fl = bf2f(fraw[s]);
            const float ex = __expf(-fl), sg = __builtin_amdgcn_rcpf(1.f + ex), f = lbv + (1.f - lbv) * sg, kk = (1.f - lbv) * (ex * sg);
            bc += __logf(f);
            pq[(size_t)s * LDU_E] = (bf16_t)(pk2(qv * __expf(bc), 0.f) & 0xffffu); pf[(size_t)s * LDU_E] = (bf16_t)(pk2(kk * __expf(-bc), 0.f) & 0xffffu);
        }
        DEC[(size_t)(chunk0 + ch) * 1024 + cc] = __expf(bc);
    }
    __syncthreads();
    f32x4 acc[8];
#pragma unroll
    for (int dt = 0; dt < 8; ++dt) acc[dt] = (f32x4){0.f, 0.f, 0.f, 0.f};
    const int row = tid & 31, seg = tid >> 5;
    const bf16_t* src = U + (size_t)(tok0 + row) * LDU_E + h * 128 + seg * 8;
    u32x4 rk = *(const u32x4*)(src + 3072), ri = *(const u32x4*)(src + 4096);
    float rdec = (tid < 128) ? DEC[(size_t)chunk0 * 1024 + h * 128 + tid] : 1.f, dtot = 1.f;
    LAS unsigned char* KT = lds; LAS unsigned char* IT = lds + 10240; LAS float* dec = (LAS float*)(lds + 20480);
    for (int ch = 0; ch < 8; ++ch) {
        tr_write8(KT, 80, row * 2, seg * 8, rk); tr_write8(IT, 80, row * 2, seg * 8, ri);
        if (tid < 128) { dec[tid] = rdec; dtot *= rdec; }
        if (ch < 7) { const bf16_t* s2 = src + (size_t)(ch + 1) * 32 * LDU_E; rk = *(const u32x4*)(s2 + 3072); ri = *(const u32x4*)(s2 + 4096);
            if (tid < 128) rdec = DEC[(size_t)(chunk0 + ch + 1) * 1024 + h * 128 + tid]; }
        __syncthreads();
        const bf16x8 bi = *(const LAS bf16x8*)(IT + (16 * w + r16) * 80 + g * 16);
#pragma unroll
        for (int dt = 0; dt < 8; ++dt) {
            const bf16x8 a = *(const LAS bf16x8*)(KT + (16 * dt + r16) * 80 + g * 16);
            acc[dt] = mfma16(a, bi, acc[dt]);
            const f32x4 dv = *(const LAS f32x4*)(dec + 16 * dt + 4 * g);
            acc[dt] *= dv;
        }
        __syncthreads();
    }
    float* SE = (float*)(P.ws + WS_SE) + (size_t)u * 16384;
#pragma unroll
    for (int dt = 0; dt < 8; ++dt)
#pragma unroll
        for (int j = 0; j < 4; ++j) SE[(16 * dt + 4 * g + j) * 128 + 16 * w + r16] = acc[dt][j];
    if (tid < 128) ((float*)(P.ws + WS_DT))[u * 128 + tid] = dtot;
}

DI void hgrn_scan_phase(const Params& P) {
    float* SE = (float*)(P.ws + WS_SE); const float* DT = (const float*)(P.ws + WS_DT);
    const int NT = gridDim.x * NTH;
    for (int e = opq_bid() * NTH + opq_tid(); e < 16 * 16384; e += NT) {
        const int bh = e >> 14, idx = e & 16383, d = idx >> 7;
        float S = 0.f;
#pragma unroll 8
        for (int sc = 0; sc < 32; ++sc) { const int u = bh * 32 + sc; const float tmp = SE[(size_t)u * 16384 + idx]; SE[(size_t)u * 16384 + idx] = S; S = DT[u * 128 + d] * S + tmp; }
    }
}

DI void hgrn_passC(const Params& P, LAS unsigned char* lds, int u) {
    const int tid = opq_tid(), lane = tid & 63, w = tid >> 6, g = lane >> 4, r16 = lane & 15;
    const int b = u >> 8, h = (u >> 5) & 7, sc = u & 31, tok0 = b * SEQ + sc * 256, chunk0 = tok0 >> 5;
    const bf16_t* U = (const bf16_t*)(P.ws + WS_U); const float* DEC = (const float*)(P.ws + WS_DEC);
    bf16_t* Y = (bf16_t*)(P.ws + WS_XN);
    LAS unsigned char* Qs = lds; LAS unsigned char* Ks = lds + 8704; LAS unsigned char* KT = lds + HG_KT; LAS unsigned char* IT = lds + HG_IT;
    LAS unsigned char* Ps = lds + HG_P; LAS unsigned char* ST = lds + HG_ST; LAS float* Os = (LAS float*)(lds + HG_O); LAS float* dec = (LAS float*)(lds + HG_DEC);
    f32x4 acc[8];
    { const float* SEb = (const float*)(P.ws + WS_SE); const float* DTb = (const float*)(P.ws + WS_DT);
      f32x4 W[8];
#pragma unroll
      for (int dt = 0; dt < 8; ++dt) { acc[dt] = (f32x4){0.f, 0.f, 0.f, 0.f}; W[dt] = (f32x4){1.f, 1.f, 1.f, 1.f}; }
#pragma unroll 1
      for (int jj = sc - 1; jj >= 0; --jj) {
          const int uj = (u - sc) + jj; const float* SE = SEb + (size_t)uj * 16384; const float* DT = DTb + uj * 128;
          float wmax = 0.f;
#pragma unroll
          for (int dt = 0; dt < 8; ++dt) {
              const f32x4 dv = *(const f32x4*)(DT + 16 * dt + 4 * g);
#pragma unroll
              for (int j = 0; j < 4; ++j) acc[dt][j] += W[dt][j] * SE[(16 * dt + 4 * g + j) * 128 + 16 * w + r16];
              W[dt] *= dv; wmax = fmaxf(wmax, fmaxf(fmaxf(W[dt][0], W[dt][1]), fmaxf(W[dt][2], W[dt][3]))); }
          if (!__any(wmax > 0.f)) break;
      }
#pragma unroll
      for (int dt = 0; dt < 8; ++dt) {
          u32x2 pw; pw.x = pk2(acc[dt][0], acc[dt][1]); pw.y = pk2(acc[dt][2], acc[dt][3]);
          *(LAS u32x2*)(ST + (16 * w + r16) * 272 + (16 * dt + 4 * g) * 2) = pw; } }
    const int row = tid & 31, seg = tid >> 5;
    const bf16_t* src = U + (size_t)(tok0 + row) * LDU_E + h * 128 + seg * 8;
    u32x4 rq = *(const u32x4*)(src + 2048), rk = *(const u32x4*)(src + 3072), ri = *(const u32x4*)(src + 4096);
    float rdec = (tid < 128) ? DEC[(size_t)chunk0 * 1024 + h * 128 + tid] : 1.f;
    const int nc = tid >> 4, nv0 = (tid & 15) * 8;
    f32x4 ng0 = *(const f32x4*)(P.hg + h * 128 + nv0), ng1 = *(const f32x4*)(P.hg + h * 128 + nv0 + 4);
    for (int ch = 0; ch < 8; ++ch) {
        *(LAS u32x4*)(Qs + row * 272 + seg * 16) = rq; *(LAS u32x4*)(Ks + row * 272 + seg * 16) = rk;
        tr_write8(KT, 80, row * 2, seg * 8, rk); tr_write8(IT, 80, row * 2, seg * 8, ri);
        if (tid < 128) dec[tid] = rdec;
        if (ch < 7) { const bf16_t* s2 = src + (size_t)(ch + 1) * 32 * LDU_E; rq = *(const u32x4*)(s2 + 2048); rk = *(const u32x4*)(s2 + 3072); ri = *(const u32x4*)(s2 + 4096);
            if (tid < 128) rdec = DEC[(size_t)(chunk0 + ch + 1) * 1024 + h * 128 + tid]; }
        const u32x4 gv = *(const u32x4*)(U + (size_t)(tok0 + ch * 32 + nc) * LDU_E + 5120 + h * 128 + nv0);
        __syncthreads();
        f32x4 ao[2];
#pragma unroll
        for (int ci = 0; ci < 2; ++ci) { ao[ci] = (f32x4){0.f, 0.f, 0.f, 0.f};
#pragma unroll
            for (int ks = 0; ks < 4; ++ks) { const bf16x8 a = *(const LAS bf16x8*)(Qs + (16 * ci + r16) * 272 + (32 * ks + 8 * g) * 2);
                const bf16x8 bs = *(const LAS bf16x8*)(ST + (16 * w + r16) * 272 + (32 * ks + 8 * g) * 2);
                ao[ci] = mfma16(a, bs, ao[ci]); } }
        if (w < 4) { const int ci = w >> 1, si = w & 1; f32x4 s = (f32x4){0.f, 0.f, 0.f, 0.f};
#pragma unroll
            for (int ks = 0; ks < 4; ++ks) { const bf16x8 a = *(const LAS bf16x8*)(Qs + (16 * ci + r16) * 272 + (32 * ks + 8 * g) * 2);
                const bf16x8 bk = *(const LAS bf16x8*)(Ks + (16 * si + r16) * 272 + (32 * ks + 8 * g) * 2);
                s = mfma16(a, bk, s); }
#pragma unroll
            for (int j = 0; j < 4; ++j) { const int c = 16 * ci + 4 * g + j, sidx = 16 * si + r16;
                *(LAS bf16_t*)(Ps + c * 80 + sidx * 2) = (bf16_t)f2bf(sidx <= c ? s[j] : 0.f); } }
        __syncthreads();
        const bf16x8 bi = *(const LAS bf16x8*)(IT + (16 * w + r16) * 80 + g * 16);
#pragma unroll
        for (int ci = 0; ci < 2; ++ci) { const bf16x8 a = *(const LAS bf16x8*)(Ps + (16 * ci + r16) * 80 + g * 16);
            ao[ci] = mfma16(a, bi, ao[ci]);
#pragma unroll
            for (int j = 0; j < 4; ++j) Os[(16 * ci + 4 * g + j) * 132 + 16 * w + r16] = ao[ci][j]; }
#pragma unroll
        for (int dt = 0; dt < 8; ++dt) {
            const bf16x8 a = *(const LAS bf16x8*)(KT + (16 * dt + r16) * 80 + g * 16);
            acc[dt] = mfma16(a, bi, acc[dt]);
            const f32x4 dv = *(const LAS f32x4*)(dec + 16 * dt + 4 * g);
            acc[dt] *= dv;
            u32x2 pw; pw.x = pk2(acc[dt][0], acc[dt][1]); pw.y = pk2(acc[dt][2], acc[dt][3]);
            *(LAS u32x2*)(ST + (16 * w + r16) * 272 + (16 * dt + 4 * g) * 2) = pw;
        }
        __syncthreads();
        { const f32x4 o0 = *(const LAS f32x4*)(Os + nc * 132 + nv0), o1 = *(const LAS f32x4*)(Os + nc * 132 + nv0 + 4);
          float ss = (o0.x * o0.x + o0.y * o0.y) + (o0.z * o0.z + o0.w * o0.w) + (o1.x * o1.x + o1.y * o1.y) + (o1.z * o1.z + o1.w * o1.w);
          ss += __shfl_xor(ss, 1); ss += __shfl_xor(ss, 2); ss += __shfl_xor(ss, 4); ss += __shfl_xor(ss, 8);
          const float r = rsqrtf(ss * (1.f / 128.f) + EPS);
          u32x4 wv;
          wv.x = pk2(o0.x * r * ng0.x * silu(bflo(gv.x)), o0.y * r * ng0.y * silu(bfhi(gv.x)));
          wv.y = pk2(o0.z * r * ng0.z * silu(bflo(gv.y)), o0.w * r * ng0.w * silu(bfhi(gv.y)));
          wv.z = pk2(o1.x * r * ng1.x * silu(bflo(gv.z)), o1.y * r * ng1.y * silu(bfhi(gv.z)));
          wv.w = pk2(o1.z * r * ng1.z * silu(bflo(gv.w)), o1.w * r * ng1.w * silu(bfhi(gv.w)));
          *(u32x4*)(Y + (size_t)(tok0 + ch * 32 + nc) * DM + 1024 + h * 128 + nv0) = wv; }
    }
    __syncthreads();
}

constexpr size_t WS_VTS0 = 1 * MiB, WS_VTS1 = 470 * MiB;
constexpr int SB_VOFF = 52224, SB_FLAGS = 103424;
constexpr float SB_RDONE = 150.0403f;
template <bool MASK>
DI void sb_block(const LAS unsigned char* kb, const LAS unsigned char* vb, int koff, int s0, int tq, const bf16x8 (&qb)[4], f32x4 (&o)[8], float& R, int g, int r16) {
    const float scl2 = 0.12751743082459868f;
    f32x4 z[2];
#pragma unroll
    for (int kt = 0; kt < 2; ++kt) { z[kt] = (f32x4){0.f, 0.f, 0.f, 0.f};
#pragma unroll
        for (int ks = 0; ks < 4; ++ks) { const bf16x8 a = *(const LAS bf16x8*)(kb + (koff + 16 * kt + r16) * 272 + (32 * ks + 8 * g) * 2); z[kt] = mfma16(a, qb[ks], z[kt]); } }
    float suf[2][4], TT[2];
#pragma unroll
    for (int kt = 0; kt < 2; ++kt) {
        float sp[4];
#pragma unroll
        for (int j = 0; j < 4; ++j) { const float zz = z[kt][j] * scl2; z[kt][j] = zz;
            const float v = fmaxf(zz, 0.f) + __builtin_amdgcn_logf(1.f + __builtin_amdgcn_exp2f(-fabsf(zz)));
            sp[j] = (!MASK || (s0 + 16 * kt + 4 * g + j < tq)) ? v : 0.f; }
        const float s3 = sp[3], s2 = sp[2] + s3, s1 = sp[1] + s2, s0_ = sp[0] + s1;
        const float o16 = __shfl_xor(s0_, 16), a2 = s0_ + o16, b2 = __shfl_xor(a2, 32);
        const float E = ((g & 1) == 0 ? o16 : 0.f) + (g < 2 ? b2 : 0.f);
        TT[kt] = a2 + b2; suf[kt][0] = s0_ + E; suf[kt][1] = s1 + E; suf[kt][2] = s2 + E; suf[kt][3] = s3 + E;
    }
    float base = R; float aw[2][4];
#pragma unroll
    for (int kt = 1; kt >= 0; --kt) {
#pragma unroll
        for (int j = 0; j < 4; ++j) { const float v = __builtin_amdgcn_exp2f(z[kt][j] - (base + suf[kt][j])); aw[kt][j] = (!MASK || (s0 + 16 * kt + 4 * g + j < tq)) ? v : 0.f; }
        base += TT[kt]; }
    R = base;
    u32x4 t; t.x = pk2(aw[0][0], aw[0][1]); t.y = pk2(aw[0][2], aw[0][3]); t.z = pk2(aw[1][0], aw[1][1]); t.w = pk2(aw[1][2], aw[1][3]); const bf16x8 bop = __builtin_bit_cast(bf16x8, t);
#pragma unroll
    for (int vt = 0; vt < 8; ++vt) { const LAS unsigned char* ap = vb + (16 * vt + r16) * 400 + (koff + 4 * g) * 2;
        const bf16x8 a = cat4(*(const LAS s16x4*)ap, *(const LAS s16x4*)(ap + 32)); o[vt] = mfma16(a, bop, o[vt]); }
}
DI void sb_phase(const Params& P, LAS unsigned char* lds) {
    const int tid = opq_tid(), lane = tid & 63, w = tid >> 6, g = lane >> 4, r16 = lane & 15;
    const int bid = opq_bid(), G = gridDim.x;
    const bf16_t* Uall = (const bf16_t*)(P.ws + WS_U); bf16_t* Yall = (bf16_t*)(P.ws + WS_XN);
    LAS int* flags = (LAS int*)(lds + SB_FLAGS);
    u32x4 rk[6], rv[6]; bf16x8 qn[4];
#define SB_LOAD(uu, rr) do { const int qt_ = (uu) & 63, bh_ = (uu) >> 6, b_ = bh_ >> 4, h_ = bh_ & 15, ks_ = qt_ * 128 + 128 - 192 * ((rr) + 1); \
        const bf16_t* Ub_ = Uall + (size_t)b_ * SEQ * LDU_O + 2048 + h_ * 128; const bf16_t* Vb_ = (const bf16_t*)(P.ws + (b_ ? WS_VTS1 : WS_VTS0)) + (size_t)h_ * 128 * SEQ; \
        _Pragma("unroll") for (int i = 0; i < 6; ++i) { const int p = tid + NTH * i; int kg = ks_ + (p >> 4); kg = kg < 0 ? 0 : kg; rk[i] = *(const u32x4*)(Ub_ + (size_t)kg * LDU_O + (p & 15) * 8); \
            const int v_ = p / 24, sg_ = p - 24 * v_; int kc = ks_ + sg_ * 8; kc = kc < 0 ? 0 : kc; rv[i] = *(const u32x4*)(Vb_ + (size_t)v_ * SEQ + kc); } } while (0)
#define SB_LOADQ(uu) do { const int qt_ = (uu) & 63, bh_ = (uu) >> 6, b_ = bh_ >> 4, h_ = bh_ & 15; const bf16_t* qp_ = Uall + ((size_t)b_ * SEQ + qt_ * 128 + 16 * w + r16) * LDU_O + h_ * 128 + 8 * g; \
        _Pragma("unroll") for (int ks = 0; ks < 4; ++ks) qn[ks] = *(const bf16x8*)(qp_ + 32 * ks); } while (0)
    int u = bid, r = 0;
    if (u >= 2048) return;
    SB_LOAD(u, 0); SB_LOADQ(u);
    bf16x8 qb[4]; f32x4 o[8]; float R = 0.f;
#pragma unroll
    for (int ks = 0; ks < 4; ++ks) qb[ks] = qn[ks];
#pragma unroll
    for (int vt = 0; vt < 8; ++vt) o[vt] = (f32x4){0.f, 0.f, 0.f, 0.f};
    for (;;) {
        const int qt = u & 63, bh = u >> 6, b = bh >> 4, h = bh & 15, t0 = qt * 128, tq = t0 + 16 * w + r16, twmax = t0 + 16 * w + 15;
        const int kstart = t0 + 128 - 192 * (r + 1);
#pragma unroll
        for (int i = 0; i < 6; ++i) { const int p = tid + NTH * i; *(LAS u32x4*)(lds + (p >> 4) * 272 + (p & 15) * 16) = rk[i];
            const int v_ = p / 24, sg_ = p - 24 * v_; *(LAS u32x4*)(lds + SB_VOFF + v_ * 400 + sg_ * 16) = rv[i]; }
        const bool spec_same = (r == 0) && (kstart > 0);
        const int nu = spec_same ? u : u + G, nr = spec_same ? 1 : 0;
        if (nu < 2048) { SB_LOAD(nu, nr); if (!spec_same) SB_LOADQ(nu); }
        __syncthreads();
#pragma unroll 1
        for (int hb = 5; hb >= 0; --hb) { const int s0 = kstart + 32 * hb;
            if (s0 < 0) break;
            if (s0 >= twmax) continue;
            if (__all(R > SB_RDONE)) break;
            if (s0 + 32 > twmax - 15) sb_block<true>(lds, lds + SB_VOFF, 32 * hb, s0, tq, qb, o, R, g, r16);
            else sb_block<false>(lds, lds + SB_VOFF, 32 * hb, s0, tq, qb, o, R, g, r16); }
        if (lane == 0) flags[w] = __all(R > SB_RDONE) ? 1 : 0;
        __syncthreads();
        if (spec_same) { r = 1; continue; }
        int alld = 1;
#pragma unroll
        for (int i = 0; i < 8; ++i) alld &= flags[i];
        if (alld || kstart <= 0) {
            { const bf16_t* gp = Uall + ((size_t)b * SEQ + tq) * LDU_O + 6144 + h * 128 + 4 * g; bf16_t* yp = (bf16_t*)Uall + ((size_t)b * SEQ + tq) * LDU_O + h * 128 + 4 * g;
#pragma unroll
              for (int vt = 0; vt < 8; ++vt) { const u32x2 gv = *(const u32x2*)(gp + 16 * vt);
                  u32x2 wv; wv.x = pk2(o[vt][0] * silu(bflo(gv.x)), o[vt][1] * silu(bfhi(gv.x))); wv.y = pk2(o[vt][2] * silu(bflo(gv.y)), o[vt][3] * silu(bfhi(gv.y)));
                  *(u32x2*)(yp + 16 * vt) = wv; } }
            u = nu; r = 0; R = 0.f;
            if (u >= 2048) break;
#pragma unroll
            for (int ks = 0; ks < 4; ++ks) qb[ks] = qn[ks];
#pragma unroll
            for (int vt = 0; vt < 8; ++vt) o[vt] = (f32x4){0.f, 0.f, 0.f, 0.f};
        } else {
            r = r + 1; SB_LOAD(u, r);
        }
    }
#undef SB_LOAD
#undef SB_LOADQ
    __syncthreads();
}

DI void final_norm_phase(const Params& P) {
    const int tid_ = opq_tid(), lane = tid_ & 63, gw = opq_bid() * 8 + (tid_ >> 6), NGW = gridDim.x * 8;
    const bf16_t* X = (const bf16_t*)(P.ws + WS_XN); const float* SS = (const float*)(P.ws + WS_SS) + 3 * MT;
    for (int mrow = gw; mrow < MT; mrow += NGW) {
        const u32x4* xr = (const u32x4*)(X + (size_t)mrow * DM) + lane; f32x4* orow = (f32x4*)(P.out + (size_t)mrow * DM); const f32x4* gr = (const f32x4*)P.g_fin;
        const float r = rsqrtf(SS[mrow] * (1.f / DM) + EPS);
        u32x4 v[4];
#pragma unroll
        for (int j = 0; j < 4; ++j) v[j] = __builtin_nontemporal_load(xr + 64 * j);
#pragma unroll
        for (int j = 0; j < 4; ++j) { const int c4 = (64 * j + lane) * 2; const f32x4 g0 = gr[c4], g1 = gr[c4 + 1];
            __builtin_nontemporal_store((f32x4){bflo(v[j].x) * r * g0.x, bfhi(v[j].x) * r * g0.y, bflo(v[j].y) * r * g0.z, bfhi(v[j].y) * r * g0.w}, orow + c4);
            __builtin_nontemporal_store((f32x4){bflo(v[j].z) * r * g1.x, bfhi(v[j].z) * r * g1.y, bflo(v[j].w) * r * g1.z, bfhi(v[j].w) * r * g1.w}, orow + c4 + 1); }
    }
}

#define XB_TMO      128
#define XB_XCNT(j)  (256  + 64 * (j))
#define XB_XSUB(j)  (1280 + 64 * (j))
#define XB_XGEN(j)  (2304 + 64 * (j))
#define XB_TOP      3328
#define XB_TOPGEN   3392
#define XCD_BAR_WORDS 3456
#define XB_SPIN_CAP (1u << 18)
DI unsigned xb_ld(unsigned* p)              { return __hip_atomic_load(p, __ATOMIC_RELAXED, __HIP_MEMORY_SCOPE_AGENT); }
DI unsigned xb_add(unsigned* p, unsigned v) { return __hip_atomic_fetch_add(p, v, __ATOMIC_RELAXED, __HIP_MEMORY_SCOPE_AGENT); }
DI unsigned xb_xcc_id() { return (unsigned)__builtin_amdgcn_s_getreg((3 << 11) | 20) & 0xFu; }
#define XB_SPIN(cond, bar) do { unsigned _sp = 0; while (cond) { __builtin_amdgcn_s_sleep(1); \
    if ((++_sp & 255u) == 0u) { if (xb_ld(&(bar)[XB_TMO])) break; if (_sp > XB_SPIN_CAP) { atomicAdd(&(bar)[XB_TMO], 1u); break; } } } } while (0)
struct XcdBarrier { unsigned* bar; unsigned x; volatile LAS unsigned* st; };
DI XcdBarrier xcd_barrier_post(unsigned* bar, volatile LAS unsigned* st) {
    XcdBarrier b; b.bar = bar; b.x = xb_xcc_id(); b.st = st;
    if (threadIdx.x == 0) (void)xb_add(&bar[XB_XCNT(b.x)], 1u);
    return b;
}
DI void xcd_barrier_complete(unsigned* bar, unsigned x, unsigned& nloc, unsigned& nx) {
    const unsigned G = gridDim.x * gridDim.y * gridDim.z;
    unsigned sum, cnt, mine, sp = 0u;
    for (;;) {
        sum = 0u; cnt = 0u; mine = 0u;
#pragma unroll
        for (unsigned j = 0; j < 16; ++j) { const unsigned c = xb_ld(&bar[XB_XCNT(j)]); sum += c; cnt += (c > 0u) ? 1u : 0u; mine = (j == x) ? c : mine; }
        if (sum == G) break;
        __builtin_amdgcn_s_sleep(1);
        if ((++sp & 255u) == 0u) { if (xb_ld(&bar[XB_TMO])) break; if (sp > XB_SPIN_CAP) { atomicAdd(&bar[XB_TMO], 1u); break; } }
    }
    nloc = mine > 0u ? mine : 1u; nx = cnt > 0u ? cnt : 1u;
}
DI void xcd_barrier(const XcdBarrier& b) {
    asm volatile("s_waitcnt vmcnt(0)" ::: "memory");
    __syncthreads();
    if (threadIdx.x == 0) {
        unsigned* bar = b.bar;
        __builtin_amdgcn_s_waitcnt(0);
        unsigned nloc = b.st[0], nx = b.st[1];
        if (nloc == 0u) { xcd_barrier_complete(bar, b.x, nloc, nx); b.st[0] = nloc; b.st[1] = nx; }
        const unsigned old = xb_add(&bar[XB_XSUB(b.x)], 1u);
        const unsigned gen = old / nloc;
        if (old + 1u == (gen + 1u) * nloc) {
            __builtin_amdgcn_fence(__ATOMIC_RELEASE, "agent");
            asm volatile("s_waitcnt vmcnt(0)" ::: "memory");
            const unsigned og = xb_add(&bar[XB_TOP], 1u);
            const unsigned tg = og / nx;
            if (og + 1u == (tg + 1u) * nx) xb_add(&bar[XB_TOPGEN], 1u);
            else XB_SPIN(xb_ld(&bar[XB_TOPGEN]) == tg, bar);
            __builtin_amdgcn_fence(__ATOMIC_ACQUIRE, "agent");
            xb_add(&bar[XB_XGEN(b.x)], 1u);
            asm volatile("s_waitcnt vmcnt(0)" ::: "memory");
        } else {
            XB_SPIN(xb_ld(&bar[XB_XGEN(b.x)]) == gen, bar);
            __builtin_amdgcn_fence(__ATOMIC_ACQUIRE, "agent");
            asm volatile("s_waitcnt vmcnt(0)" ::: "memory");
        }
    }
    __syncthreads();
}

__global__ void __launch_bounds__(NTH, 2) fwd_megakernel(Params P0) {
    extern __shared__ __attribute__((aligned(16))) unsigned char lds_raw[];
    LAS unsigned char* lds = (LAS unsigned char*)lds_raw;
    cg::grid_group grid = cg::this_grid();
    if (threadIdx.x < 4) ((LAS unsigned*)(lds + LDS_BARST))[threadIdx.x] = 0u;
    __syncthreads();
    const XcdBarrier xbar = xcd_barrier_post((unsigned*)P0.ws, (volatile LAS unsigned*)(lds + LDS_BARST));
    const int G = gridDim.x, nph = P0.nph;

    if (nph < 0) grid.sync();
    constexpr unsigned GEMM_MASK = (1u << 1) | (1u << 2) | (1u << 4) | (1u << 5) | (1u << 7) | (1u << 9) | (1u << 11) | (1u << 13) | (1u << 15) | (1u << 17);
#pragma unroll 1
    for (int ph = 0; ph < nph; ++ph) {
        Params P = P0; { unsigned char* w_ = P0.ws; asm volatile("" : "+s"(w_)); P.ws = w_; }
        unsigned char* ws = P.ws; const int bid = opq_bid();
        bf16_t* XN = (bf16_t*)(ws + WS_XN); bf16_t* Ub = (bf16_t*)(ws + WS_U);
        if (ph == 3 || ph == 6 || ph == 8 || ph == 10 || ph == 14 || ph == 16) continue;
        const int nrep = ((PROBE_MASK >> ph) & 1u) ? 2 : 1;
        for (int rep = 0; rep < nrep; ++rep) {
        if (rep) __syncthreads();
        if (ph == 0) prologue(P, lds);
        else if (ph == 2) { pool_mix_phase(P); for (int u = bid; u < 512; u += G) hgrn_passA(P, lds, u, rep > 0); }
        else if (ph == 3) { if (rep == 0) hgrn_scan_phase(P); }
        else if (ph == 4) { for (int u = bid; u < 512; u += G) hgrn_passC(P, lds, u); }
        else if (ph == 12) sb_phase(P, lds);
        else if (ph == 18) final_norm_phase(P);
        if ((GEMM_MASK >> ph) & 1u) {
            pg8::Sched S; pg8::Epi E{};
            const int layer = (ph >= 12) ? 1 : 0;
            bf16_t* XN2 = (bf16_t*)(ws + WS_U + 64 * MiB);
            bf16_t* BtS = (bf16_t*)(ws + (layer ? 89 : 1) * MiB); bf16_t* BtN = (bf16_t*)(ws + (layer ? 97 : 9) * MiB);
            const bf16_t* A = (ph == 9 || ph == 13 || ph == 17) ? Ub : ((ph == 7) ? XN2 : XN); const bf16_t* Bt; int N = DM, K = DM, lda = DM, ldb = DM, apn = 0; long bbs = 0;
            E.MODE = (ph == 5 || ph == 9 || ph == 13 || ph == 17) ? 1 : (ph == 4 ? 2 : ((ph == 7 || ph == 15) ? 3 : 0)); E.PERM = true;
            E.O = Ub; E.ldc = DM; E.KX = (bf16_t*)(ws + WS_KX); E.VX = (bf16_t*)(ws + WS_VT); E.BtS = BtS; E.BtN = BtN; E.BtS1 = (bf16_t*)(ws + 89 * MiB); E.BtN1 = (bf16_t*)(ws + 97 * MiB); E.res = (ph == 5) ? P.x : nullptr; E.resb = (ph == 9) ? XN2 : ((ph == 13 || ph == 17) ? XN : nullptr); E.out = P.out; E.xr_out = (ph == 5) ? XN2 : XN; E.gate = Ub + 1024; E.pscale = P.pool_s;
            { float* SS = (float*)(ws + WS_SS); const int si = (ph == 5 || ph == 7) ? 0 : ((ph == 9 || ph == 11) ? 1 : ((ph == 17) ? 3 : 2));
              const bool prod = (ph == 5 || ph == 9 || ph == 13 || ph == 17), cons = (ph == 7 || ph == 11 || ph == 15);
              E.ss_out = prod ? SS + si * MT : nullptr; E.ss_in = cons ? SS + si * MT : nullptr; }
            E.vt_lo = (ph == 11) ? 16 : (1 << 20); E.VTS0 = (bf16_t*)(ws + WS_VTS0); E.VTS1 = (bf16_t*)(ws + WS_VTS1);
            if (ph == 1) { Bt = (const bf16_t*)(ws + WS_WINE); N = 6144; E.ldc = LDU_E; }
            else if (ph == 2) { Bt = nullptr; K = 512; }
            else if (ph == 4) { A = (const bf16_t*)(ws + WS_MIX); Bt = (const bf16_t*)(ws + WS_POOLT); N = 1024; K = 256; lda = 1024; ldb = 256; apn = 512; E.O = XN; }
            else if (ph == 5) Bt = (const bf16_t*)(ws + WS_WOUTE);
            else if (ph == 7 || ph == 15) { Bt = BtS; N = 1024; bbs = 1024L * DM; E.ldc = 1024; }
            else if (ph == 9 || ph == 17) { Bt = BtN; K = 1024; lda = 1024; ldb = 1024; bbs = 2048L * 1024; }
            else if (ph == 11) { Bt = (const bf16_t*)(ws + WS_WINO); N = 8192; E.ldc = LDU_O; }
            else { Bt = (const bf16_t*)(ws + WS_WOUTO); lda = LDU_O; }
            S.init(A, Bt, MT, N, K, lda, ldb, apn); S.b_batch_stride = bbs;
            if (ph == 1) { S.n_extra = 64; S.A2 = (const bf16_t*)(ws + WS_HM); S.B2 = (const bf16_t*)(ws + WS_WKV); }
            if (ph == 2) { S.pre = 1; S.KXl = (const bf16_t*)(ws + WS_KX); S.VXl = (const bf16_t*)(ws + WS_VT); S.WQp = (const bf16_t*)(ws + WS_WQ); S.WOt = (const bf16_t*)(ws + WS_WO); }
            pg8::gemm_phase(lds, S, E);
        }
        }
        if (ph + 1 < nph) xcd_barrier(xbar);
#ifdef PROBE_SYNCS
        if (ph == 5) { for (int i = 0; i < PROBE_SYNCS; ++i) xcd_barrier(xbar); }
#endif
    }
}

extern "C" void kernel_launch(void* const* d_in, const int* in_sizes, int n_in, void* d_out, int out_size, void* d_ws, size_t ws_size, hipStream_t stream) {
    static int grid = 0;
    if (grid == 0) {
        if (n_in != 17 || out_size != MT * DM || ws_size < WS_END) { fprintf(stderr, "kernel_launch: unexpected shapes (n_in %d out %d ws %zu)\n", n_in, out_size, ws_size); grid = -1; return; }
        int dev = 0, cus = 0, per_cu = 0;
        (void)hipGetDevice(&dev);
        (void)hipDeviceGetAttribute(&cus, hipDeviceAttributeMultiprocessorCount, dev);
        if (hipFuncSetAttribute((const void*)fwd_megakernel, hipFuncAttributeMaxDynamicSharedMemorySize, LDS_BYTES) != hipSuccess) { fprintf(stderr, "kernel_launch: hipFuncSetAttribute failed\n"); grid = -1; return; }
        if (hipOccupancyMaxActiveBlocksPerMultiprocessor(&per_cu, (const void*)fwd_megakernel, NTH, LDS_BYTES) != hipSuccess || per_cu < 1) { fprintf(stderr, "kernel_launch: occupancy query failed (%d)\n", per_cu); per_cu = 1; }
        (void)hipGetLastError();
        grid = cus * per_cu;
        fprintf(stderr, "kernel_launch: grid %d (cus %d x %d)\n", grid, cus, per_cu);
    }
    if (grid < 0) return;
    Params p{};
    const float** pp = (const float**)&p;
    for (int i = 0; i < 17; ++i) pp[i] = (const float*)d_in[i];
    p.out = (float*)d_out; p.ws = (unsigned char*)d_ws; p.nph = 19;
    if (hipMemsetAsync(d_ws, 0, 16384, stream) != hipSuccess) { fprintf(stderr, "kernel_launch: memset failed\n"); return; }
    void* args[] = {&p};
    hipError_t e = hipLaunchCooperativeKernel((const void*)fwd_megakernel, dim3(grid), dim3(NTH), args, LDS_BYTES, stream);
    if (e != hipSuccess) fprintf(stderr, "cooperative launch failed: %s (grid %d)\n", hipGetErrorString(e), grid);
}
```

```cpp
#include <hip/hip_runtime.h>
#include <hip/hip_cooperative_groups.h>
#include <cstdio>
namespace cg = cooperative_groups;

#define DI __device__ __forceinline__
#define LAS __attribute__((address_space(3)))
typedef unsigned short bf16_t;
typedef short bf16x8 __attribute__((ext_vector_type(8)));
typedef short s16x4 __attribute__((ext_vector_type(4)));
typedef float f32x4 __attribute__((ext_vector_type(4)));
typedef unsigned u32x4 __attribute__((ext_vector_type(4)));
typedef unsigned u32x2 __attribute__((ext_vector_type(2)));

constexpr int DM = 2048, SEQ = 8192, NBATCH = 2, MT = NBATCH * SEQ, MEMLEN = 256;
constexpr int NTH = 512, LDS_BYTES = 147456, LDS_BARST = 147440;
#ifndef PROBE_MASK
#define PROBE_MASK 0u
#endif
constexpr float EPS = 1e-6f;
constexpr int LDU_E = 6144, LDU_O = 8192;

constexpr size_t MiB = 1u << 20;
constexpr size_t WS_WINE = 1 * MiB, WS_WOUTE = 25 * MiB, WS_WINO = 33 * MiB, WS_WOUTO = 65 * MiB, WS_WQ = 73 * MiB, WS_WKV = 89 * MiB, WS_WO = 121 * MiB, WS_POOLT = 137 * MiB;
constexpr size_t WS_HM = 138 * MiB, WS_KX = 142 * MiB, WS_VT = 146 * MiB, WS_XN = 150 * MiB, WS_U = 214 * MiB;
constexpr size_t WS_MIX = 406 * MiB;
constexpr size_t WS_SE = 470 * MiB;
constexpr size_t WS_DT = 502 * MiB;
constexpr size_t WS_DEC = 503 * MiB;
constexpr size_t WS_SS = 502 * MiB + 512 * 1024;
constexpr size_t WS_END = 512 * MiB;

struct Params {
    const float *x, *mem, *g_mix, *g_xa, *g_mem, *g_fin, *w_in_e, *pool_w, *pool_s, *lb, *hg, *w_out_e, *w_in_o, *w_out_o, *wq, *wkv, *wo;
    float* out; unsigned char* ws; int nph, pad;
};

DI unsigned f2bf(float f) { unsigned u = __builtin_bit_cast(unsigned, f); return (u + 0x7fffu + ((u >> 16) & 1u)) >> 16; }
typedef __bf16 bf16x2_t __attribute__((ext_vector_type(2)));
typedef float f32x2_t __attribute__((ext_vector_type(2)));
DI unsigned pk2(float lo, float hi) { f32x2_t f = {lo, hi}; bf16x2_t v = __builtin_convertvector(f, bf16x2_t); return __builtin_bit_cast(unsigned, v); }
DI float bf2f(unsigned v) { return __builtin_bit_cast(float, v << 16); }
DI float bflo(unsigned w) { return __builtin_bit_cast(float, w << 16); }
DI float bfhi(unsigned w) { return __builtin_bit_cast(float, w & 0xffff0000u); }
DI float wave_sum(float v) {
#pragma unroll
    for (int o = 1; o < 64; o <<= 1) v += __shfl_xor(v, o);
    return v;
}
DI int opq_tid() { int t = threadIdx.x; asm volatile("" : "+v"(t)); return t; }
DI int opq_bid() { int b = blockIdx.x; asm volatile("" : "+s"(b)); return b; }
DI float silu(float v) { return v / (1.f + __expf(-v)); }
DI f32x4 mfma16(bf16x8 a, bf16x8 b, f32x4 c) { return __builtin_amdgcn_mfma_f32_16x16x32_bf16(a, b, c, 0, 0, 0); }
DI bf16x8 cat4(s16x4 lo, s16x4 hi) { return __builtin_shufflevector(lo, hi, 0, 1, 2, 3, 4, 5, 6, 7); }

namespace pg8 {
constexpr int BM = 256, BK = 64, HALF = 128, HTB = HALF * BK * 2, STAGE_BYTES = 8 * HTB, NXCD = 8, WGM = 8;
DI int lds_byte(int r, int c) { const int st = (r >> 4) * 2 + (c >> 5), rr = r & 15, cc = c & 31, ob = rr * 64 + cc * 2; return st * 1024 + (ob ^ (((ob >> 9) & 1) << 5)); }
DI void stage_rc(int b, int& R, int& C) { const int st = b / 1024, sb = b % 1024, swz = sb ^ (((sb >> 9) & 1) << 5); R = (st >> 1) * 16 + swz / 64; C = (st & 1) * 32 + (swz % 64) / 2; }
DI int perm32(int rho) { const int n = rho >> 4, i = rho & 15; return 8 * (i >> 2) + 4 * n + (i & 3); }
DI unsigned cvt_pk_bf16(float lo, float hi) { unsigned r; asm volatile("v_cvt_pk_bf16_f32 %0, %1, %2" : "=v"(r) : "v"(lo), "v"(hi)); return r; }

struct Unit { int pm, pn, gi; };
struct Sched {
    const bf16_t* A; const bf16_t* Bt; int lda, ldb, a_pn_bytes, K; long b_batch_stride;
    int nM, nN, nwg, G, c;
    int n_extra; const bf16_t* A2; const bf16_t* B2;
    int pre; const bf16_t* KXl; const bf16_t* VXl; const bf16_t* WQp; const bf16_t* WOt;
    DI void init(const bf16_t* A_, const bf16_t* Bt_, int M, int N, int K_, int lda_, int ldb_, int a_pn_bytes_) {
        A = A_; Bt = Bt_; lda = lda_; ldb = ldb_; a_pn_bytes = a_pn_bytes_; K = K_; b_batch_stride = 0; nM = M / BM; nN = N / BM; nwg = nM * nN; G = gridDim.x; c = opq_bid(); n_extra = 0; A2 = nullptr; B2 = nullptr;
        pre = 0; KXl = nullptr; VXl = nullptr; WQp = nullptr; WOt = nullptr;
    }
    DI bool next(int i, Unit& u) const {
        const long L = (long)i * G + c;
        const long total = pre ? 256 : (long)(nwg + n_extra);
        if (L >= total) return false;
        const bool ex = (!pre) && (L >= nwg); const int e = (int)(L - nwg), Li = (int)L;
        int wgid = (ex || pre) ? 0 : Li; { const int q = nwg / NXCD, r = nwg % NXCD, xcd = wgid % NXCD, off = wgid / NXCD; wgid = (xcd < r ? xcd * (q + 1) : r * (q + 1) + (xcd - r) * q) + off; }
        const int nig = WGM * nN, gid = wgid / nig, fm = gid * WGM, gsz = (nM - fm) < WGM ? (nM - fm) : WGM;
        const int pm0 = fm + ((wgid % nig) % gsz), pn0 = (wgid % nig) / gsz;
        u.pm = pre ? (Li & 7) : (ex ? ((e & 31) >> 4) : pm0);
        u.pn = pre ? ((Li >> 3) & 7) : (ex ? (e & 15) : pn0);
        u.gi = pre ? 3 + ((Li >> 6) & 1) + 2 * (Li >> 7) : (ex ? 1 + (e >> 5) : 0);
        return true;
    }
    DI const char* pa(const Unit& u) const {
        const int b = u.pn >> 2, h = u.pn & 3; const bf16_t* p;
        if (u.gi == 0) p = A + (size_t)u.pm * BM * (size_t)lda + (size_t)u.pn * (a_pn_bytes >> 1);
        else if (u.gi <= 2) p = A2 + ((size_t)(u.gi - 1) * 512 + (size_t)u.pm * BM) * (size_t)lda;
        else if (((u.gi - 3) & 1) == 0) p = KXl + (size_t)((u.gi - 3) >> 1) * 512 * DM + (size_t)(b * 256) * DM + h * 512;
        else p = WOt + (size_t)((u.gi - 3) >> 1) * DM * DM + (size_t)(u.pm * 256) * DM + h * 512;
        return (const char*)p;
    }
    DI const char* pb(const Unit& u) const {
        const int b = u.pn >> 2, h = u.pn & 3; const bf16_t* p;
        if (u.gi == 0) p = Bt + (size_t)(u.pm >> 5) * (size_t)b_batch_stride + (size_t)u.pn * BM * (size_t)ldb;
        else if (u.gi <= 2) p = B2 + ((size_t)(u.gi - 1) * 4096 + (size_t)u.pn * BM) * (size_t)ldb;
        else if (((u.gi - 3) & 1) == 0) p = WQp + (size_t)((u.gi - 3) >> 1) * DM * DM + (size_t)(u.pm * 256) * DM + h * 512;
        else p = VXl + (size_t)((u.gi - 3) >> 1) * 512 * DM + (size_t)(b * 256) * DM + h * 512;
        return (const char*)p;
    }
};

struct Epi {
    int MODE; bool PERM;
    bf16_t* O; int ldc;
    bf16_t* KX; bf16_t* VX;
    bf16_t* BtS1; bf16_t* BtN1; bf16_t* BtS; bf16_t* BtN;
    int vt_lo; bf16_t* VTS0; bf16_t* VTS1;
    const float* res; const bf16_t* resb; float* out; bf16_t* xr_out; float* ss_out;
    const float* ss_in;
    const bf16_t* gate; const float* pscale;
    DI void operator()(const f32x4 (&acc)[2][2][4][2], const Unit& u, int wr, int wc, int fr, int fq) const {
        if (MODE == 1) {
            const int row0 = u.pm * BM + wr * 64 + fr, col0 = u.pn * BM + wc * 32 + 8 * fq;
#pragma unroll
            for (int ai = 0; ai < 2; ++ai) {
                f32x4 rr[4][2][2];
                if (resb) {
                    u32x4 rb[4][2];
#pragma unroll
                    for (int m = 0; m < 4; ++m)
#pragma unroll
                        for (int bj = 0; bj < 2; ++bj) rb[m][bj] = *(const u32x4*)(resb + (size_t)(row0 + ai * HALF + m * 16) * DM + col0 + bj * HALF);
#pragma unroll
                    for (int m = 0; m < 4; ++m)
#pragma unroll
                        for (int bj = 0; bj < 2; ++bj) { rr[m][bj][0] = (f32x4){bflo(rb[m][bj].x), bfhi(rb[m][bj].x), bflo(rb[m][bj].y), bfhi(rb[m][bj].y)};
                            rr[m][bj][1] = (f32x4){bflo(rb[m][bj].z), bfhi(rb[m][bj].z), bflo(rb[m][bj].w), bfhi(rb[m][bj].w)}; }
                } else {
#pragma unroll
                    for (int m = 0; m < 4; ++m)
#pragma unroll
                        for (int bj = 0; bj < 2; ++bj)
#pragma unroll
                            for (int n = 0; n < 2; ++n) rr[m][bj][n] = __builtin_nontemporal_load((const f32x4*)(res + (size_t)(row0 + ai * HALF + m * 16) * DM + col0 + bj * HALF + 4 * n));
                }
#pragma unroll
                for (int m = 0; m < 4; ++m) { const int row = row0 + ai * HALF + m * 16; const size_t ro = (size_t)row * DM + col0; float ssq = 0.f;
#pragma unroll
                    for (int bj = 0; bj < 2; ++bj) { const f32x4 v0 = acc[ai][bj][m][0] + rr[m][bj][0], v1 = acc[ai][bj][m][1] + rr[m][bj][1];
                        if (xr_out) { u32x4 w; w.x = pk2(v0[0], v0[1]); w.y = pk2(v0[2], v0[3]); w.z = pk2(v1[0], v1[1]); w.w = pk2(v1[2], v1[3]); *(u32x4*)(xr_out + ro + bj * HALF) = w; }
                        else { *(f32x4*)(out + ro + bj * HALF) = v0; *(f32x4*)(out + ro + bj * HALF + 4) = v1; }
                        ssq += ((v0[0] * v0[0] + v0[1] * v0[1]) + (v0[2] * v0[2] + v0[3] * v0[3])) + ((v1[0] * v1[0] + v1[1] * v1[1]) + (v1[2] * v1[2] + v1[3] * v1[3])); }
                    if (ss_out) { ssq += __shfl_xor(ssq, 16); ssq += __shfl_xor(ssq, 32); if (fq == 0) atomicAdd(ss_out + row, ssq); } }
            }
        } else if (MODE == 0) {
            const int row0 = u.pm * BM + wr * 64 + fr;
            const bool sbv = (u.gi == 0) && ((unsigned)(u.pn - vt_lo) < 8u);
            if (!sbv) {
                const int bb = u.pn >> 2, hh = u.pn & 3;
                bf16_t* base; int ld, rowb, colb;
                if (u.gi == 0) { base = O; ld = ldc; rowb = u.pm * BM; colb = u.pn * BM; }
                else if (u.gi <= 2) { base = ((u.pn >= 8) ? VX : KX) + (size_t)(u.gi - 1) * 512 * DM; ld = DM; rowb = u.pm * BM; colb = (u.pn & 7) * BM; }
                else if (((u.gi - 3) & 1) == 0) { base = ((u.gi >= 5) ? BtS1 : BtS) + (size_t)(bb * 1024 + hh * 256) * DM; ld = DM; rowb = 0; colb = u.pm * BM; }
                else { base = ((u.gi >= 5) ? BtN1 : BtN) + (size_t)(bb * 2048 + u.pm * 256) * 1024; ld = 1024; rowb = 0; colb = hh * 256; }
                const int rloc = wr * 64 + fr, col0 = colb + wc * 32 + 8 * fq;
#pragma unroll
                for (int ai = 0; ai < 2; ++ai)
#pragma unroll
                    for (int m = 0; m < 4; ++m) { bf16_t* rowp = base + (size_t)(rowb + rloc + ai * HALF + m * 16) * ld + col0;
                        const float rs_ = ss_in ? rsqrtf(ss_in[row0 + ai * HALF + m * 16] * (1.f / DM) + EPS) : 1.f;
#pragma unroll
                        for (int bj = 0; bj < 2; ++bj) { const f32x4 v0 = acc[ai][bj][m][0] * rs_, v1 = acc[ai][bj][m][1] * rs_;
                            u32x4 w; w.x = cvt_pk_bf16(v0[0], v0[1]); w.y = cvt_pk_bf16(v0[2], v0[3]); w.z = cvt_pk_bf16(v1[0], v1[1]); w.w = cvt_pk_bf16(v1[2], v1[3]);
                            *(u32x4*)(rowp + bj * HALF) = w; } }
            } else {
                bf16_t* base = ((u.pm * BM) >> 13) ? VTS1 : VTS0; const int ldt = SEQ, rowi = ((u.pm * BM) & (SEQ - 1)) + wr * 64 + fr, col0 = (u.pn - vt_lo) * BM + wc * 32 + 8 * fq;
#pragma unroll
                for (int ai = 0; ai < 2; ++ai)
#pragma unroll
                    for (int m = 0; m < 4; ++m) { const int row = rowi + ai * HALF + m * 16;
                        const float rs_ = ss_in ? rsqrtf(ss_in[row0 + ai * HALF + m * 16] * (1.f / DM) + EPS) : 1.f;
#pragma unroll
                        for (int bj = 0; bj < 2; ++bj)
#pragma unroll
                            for (int n = 0; n < 2; ++n)
#pragma unroll
                                for (int j = 0; j < 4; ++j) base[(size_t)(col0 + bj * HALF + 4 * n + j) * ldt + row] = (bf16_t)f2bf(acc[ai][bj][m][n][j] * rs_); }
            }
        } else {
            const int row0 = u.pm * BM + wr * 64 + fr, col0 = u.pn * BM + wc * 32 + 8 * fq;
#pragma unroll
            for (int ai = 0; ai < 2; ++ai)
#pragma unroll
                for (int m = 0; m < 4; ++m) { const int row = row0 + ai * HALF + m * 16;
#pragma unroll
                    for (int bj = 0; bj < 2; ++bj) { const int col = col0 + bj * HALF;
                        const u32x4 gv = *(const u32x4*)(gate + (size_t)row * LDU_E + col);
                        const f32x4 s0 = *(const f32x4*)(pscale + col), s1 = *(const f32x4*)(pscale + col + 4);
                        const f32x4 v0 = acc[ai][bj][m][0], v1 = acc[ai][bj][m][1];
                        u32x4 w;
                        w.x = pk2(v0[0] * s0[0] * silu(bflo(gv.x)), v0[1] * s0[1] * silu(bfhi(gv.x)));
                        w.y = pk2(v0[2] * s0[2] * silu(bflo(gv.y)), v0[3] * s0[3] * silu(bfhi(gv.y)));
                        w.z = pk2(v1[0] * s1[0] * silu(bflo(gv.z)), v1[1] * s1[1] * silu(bfhi(gv.z)));
                        w.w = pk2(v1[2] * s1[2] * silu(bflo(gv.w)), v1[3] * s1[3] * silu(bfhi(gv.w)));
                        *(u32x4*)(O + (size_t)row * ldc + col) = w; } }
        }
    }
    DI void softmax_store(f32x4 (&acc)[2][2][4][2], const Unit& u, int wr, int wc, int fr, int fq, LAS unsigned char* lds) const {
        LAS float* ex = (LAS float*)lds;
        const float scl2 = 0.06375871541229934f;
        const int rloc = wr * 64 + fr;
        float mloc[2][4];
#pragma unroll
        for (int ai = 0; ai < 2; ++ai)
#pragma unroll
            for (int m = 0; m < 4; ++m) { const int rl = rloc + ai * HALF + m * 16;
                const float rs_ = rsqrtf(ss_in[u.pm * BM + rl] * (1.f / DM) + EPS) * scl2;
                float mx = -3.0e38f;
#pragma unroll
                for (int bj = 0; bj < 2; ++bj)
#pragma unroll
                    for (int n = 0; n < 2; ++n)
#pragma unroll
                        for (int j = 0; j < 4; ++j) { const float v = acc[ai][bj][m][n][j] * rs_; acc[ai][bj][m][n][j] = v; mx = fmaxf(mx, v); }
                mx = fmaxf(mx, __shfl_xor(mx, 16)); mx = fmaxf(mx, __shfl_xor(mx, 32));
                float sm = 0.f;
#pragma unroll
                for (int bj = 0; bj < 2; ++bj)
#pragma unroll
                    for (int n = 0; n < 2; ++n)
#pragma unroll
                        for (int j = 0; j < 4; ++j) { const float e = __builtin_amdgcn_exp2f(acc[ai][bj][m][n][j] - mx); acc[ai][bj][m][n][j] = e; sm += e; }
                sm += __shfl_xor(sm, 16); sm += __shfl_xor(sm, 32);
                mloc[ai][m] = mx;
                if (fq == 0) { ex[(rl * 4 + wc) * 2] = mx; ex[(rl * 4 + wc) * 2 + 1] = sm; } }
        __syncthreads();
#pragma unroll
        for (int ai = 0; ai < 2; ++ai)
#pragma unroll
            for (int m = 0; m < 4; ++m) { const int rl = rloc + ai * HALF + m * 16;
                const f32x4 p0 = *(const LAS f32x4*)(ex + rl * 8), p1 = *(const LAS f32x4*)(ex + rl * 8 + 4);
                const float M = fmaxf(fmaxf(p0[0], p0[2]), fmaxf(p1[0], p1[2]));
                const float tot = p0[1] * __builtin_amdgcn_exp2f(p0[0] - M) + p0[3] * __builtin_amdgcn_exp2f(p0[2] - M) + p1[1] * __builtin_amdgcn_exp2f(p1[0] - M) + p1[3] * __builtin_amdgcn_exp2f(p1[2] - M);
                const float f = __builtin_amdgcn_exp2f(mloc[ai][m] - M) / tot;
                bf16_t* rowp = O + (size_t)(u.pm * BM + rl) * ldc + u.pn * BM + wc * 32 + 8 * fq;
#pragma unroll
                for (int bj = 0; bj < 2; ++bj) { const f32x4 v0 = acc[ai][bj][m][0] * f, v1 = acc[ai][bj][m][1] * f;
                    u32x4 w; w.x = cvt_pk_bf16(v0[0], v0[1]); w.y = cvt_pk_bf16(v0[2], v0[3]); w.z = cvt_pk_bf16(v1[0], v1[1]); w.w = cvt_pk_bf16(v1[2], v1[3]);
                    *(u32x4*)(rowp + bj * HALF) = w; } }
    }
};

DI void gemm_phase(LAS unsigned char* lds, const Sched& S, const Epi& Ep) {
    const int tid = opq_tid(), wid = __builtin_amdgcn_readfirstlane(tid >> 6), lane = tid & 63, wr = wid >> 2, wc = wid & 3, fr = lane & 15, fq = lane >> 4;
    const int K = S.K, nt = K / BK;
    unsigned voffA[2], voffB[2];
#pragma unroll
    for (int i = 0; i < 2; ++i) { int R, C; stage_rc(tid * 16 + i * 8192, R, C); const int Rb = Ep.PERM ? ((R & ~31) + perm32(R & 31)) : R;
        voffA[i] = (unsigned)(R * S.lda + C) * 2u; voffB[i] = (unsigned)(Rb * S.ldb + C) * 2u; }
    const size_t kstep = (size_t)(BK * 2);
    const size_t hstepA = (size_t)HALF * S.lda * 2, hstepB = (size_t)HALF * S.ldb * 2;
    const unsigned ldsw = (unsigned)wid * 1024u;
    const int aoff = lds_byte(wr * 64 + fr, fq * 8), boff = lds_byte(wc * 32 + fr, fq * 8);
#define PG8_SA(b, h) (((b) * 2 + (h)) * HTB)
#define PG8_SB(b, h) ((4 + (b) * 2 + (h)) * HTB)
#define PG8_STAGE(bufoff, gbase, voff) do { _Pragma("unroll") for (int _i = 0; _i < 2; ++_i) \
        __builtin_amdgcn_global_load_lds((const unsigned*)((const char*)(gbase) + (voff)[_i]), (LAS unsigned*)(lds + (bufoff) + ldsw + _i * 8192), 16, 0, 0); } while (0)
#define PG8_LDA(dst, b, h) do { _Pragma("unroll") for (int m = 0; m < 4; ++m) _Pragma("unroll") for (int k = 0; k < 2; ++k) dst[m][k] = *(const LAS bf16x8*)(lds + PG8_SA(b, h) + aoff + m * 2048 + k * 1024); } while (0)
#define PG8_LDB(dst, b, h) do { _Pragma("unroll") for (int n = 0; n < 2; ++n) _Pragma("unroll") for (int k = 0; k < 2; ++k) dst[n][k] = *(const LAS bf16x8*)(lds + PG8_SB(b, h) + boff + n * 2048 + k * 1024); } while (0)
#define PG8_MMA(ai, bj, At, Bt) do { __builtin_amdgcn_s_setprio(1); _Pragma("unroll") for (int m = 0; m < 4; ++m) _Pragma("unroll") for (int n = 0; n < 2; ++n) _Pragma("unroll") for (int k = 0; k < 2; ++k) \
        acc[ai][bj][m][n] = __builtin_amdgcn_mfma_f32_16x16x32_bf16(Bt[n][k], At[m][k], acc[ai][bj][m][n], 0, 0, 0); __builtin_amdgcn_s_setprio(0); } while (0)
#define PG8_WAIT_V(n) asm volatile("s_waitcnt vmcnt(" #n ")" ::: "memory")
#define PG8_WAIT_L(n) asm volatile("s_waitcnt lgkmcnt(" #n ")" ::: "memory")
#define PG8_BAR __builtin_amdgcn_s_barrier()
#define PG8_SCHED __builtin_amdgcn_sched_barrier(0)
    Unit cur, nxt; int ui = 0;
    if (!S.next(0, cur)) return;
    f32x4 acc[2][2][4][2];
#pragma unroll
    for (int a = 0; a < 2; ++a)
#pragma unroll
        for (int b = 0; b < 2; ++b)
#pragma unroll
            for (int m = 0; m < 4; ++m)
#pragma unroll
                for (int n = 0; n < 2; ++n) acc[a][b][m][n] = (f32x4){0.f, 0.f, 0.f, 0.f};
    bf16x8 At[4][2], B0[2][2], B1[2][2];
    const char* cA = S.pa(cur); const char* cB = S.pb(cur);
    PG8_STAGE(PG8_SB(0, 0), cB, voffB); PG8_STAGE(PG8_SB(0, 1), cB + hstepB, voffB); PG8_STAGE(PG8_SA(0, 0), cA, voffA); PG8_STAGE(PG8_SA(0, 1), cA + hstepA, voffA);
    if (wr == 1) PG8_BAR;
    PG8_WAIT_V(2); PG8_BAR;
    PG8_STAGE(PG8_SB(1, 0), cB + kstep, voffB); PG8_STAGE(PG8_SA(1, 0), cA + kstep, voffA); PG8_STAGE(PG8_SB(1, 1), cB + hstepB + kstep, voffB);
    PG8_WAIT_V(6); PG8_BAR;
    const bool align_epi = (Ep.MODE != 3);
    for (;;) {
        const bool has_next = S.next(ui + 1, nxt);
        const char* nA = has_next ? S.pa(nxt) : cA; const char* nB = has_next ? S.pb(nxt) : cB;
        for (int t = 0; t < nt; t += 2) {
            const bool last = (t == nt - 2);
            const char* a1 = cA + (size_t)(t + 1) * kstep;
            const char* a2 = last ? nA : cA + (size_t)(t + 2) * kstep; const char* b2 = last ? nB : cB + (size_t)(t + 2) * kstep;
            const char* a3 = a2 + kstep; const char* b3 = b2 + kstep;
            PG8_LDB(B0, 0, 0); PG8_LDB(B1, 0, 1); PG8_SCHED; PG8_LDA(At, 0, 0); PG8_STAGE(PG8_SA(1, 1), a1 + hstepA, voffA);
            PG8_WAIT_V(8); PG8_WAIT_L(0); PG8_BAR; PG8_MMA(0, 0, At, B0); PG8_MMA(0, 1, At, B1); PG8_BAR; PG8_SCHED;
            PG8_LDA(At, 0, 1); PG8_STAGE(PG8_SB(0, 0), b2, voffB); PG8_STAGE(PG8_SB(0, 1), b2 + hstepB, voffB); PG8_STAGE(PG8_SA(0, 0), a2, voffA);
            PG8_WAIT_V(8); PG8_WAIT_L(0); PG8_BAR; PG8_MMA(1, 0, At, B0); PG8_MMA(1, 1, At, B1); PG8_BAR; PG8_SCHED;
            PG8_LDB(B0, 1, 0); PG8_LDB(B1, 1, 1); PG8_SCHED; PG8_LDA(At, 1, 0); PG8_STAGE(PG8_SA(0, 1), a2 + hstepA, voffA);
            PG8_WAIT_V(8); PG8_WAIT_L(0); PG8_BAR; PG8_MMA(0, 0, At, B0); PG8_MMA(0, 1, At, B1); PG8_BAR; PG8_SCHED;
            PG8_LDA(At, 1, 1); PG8_STAGE(PG8_SB(1, 0), b3, voffB); PG8_STAGE(PG8_SB(1, 1), b3 + hstepB, voffB); PG8_STAGE(PG8_SA(1, 0), a3, voffA);
            PG8_WAIT_V(8); PG8_WAIT_L(0); PG8_BAR; PG8_MMA(1, 0, At, B0); PG8_MMA(1, 1, At, B1); PG8_BAR; PG8_SCHED;
        }
        if (align_epi) { if (wr == 0) PG8_BAR; }
        if (Ep.MODE != 3) Ep(acc, cur, wr, wc, fr, fq);
        if (!has_next) break;
#pragma unroll
        for (int a = 0; a < 2; ++a)
#pragma unroll
            for (int b = 0; b < 2; ++b)
#pragma unroll
                for (int m = 0; m < 4; ++m)
#pragma unroll
                    for (int n = 0; n < 2; ++n) acc[a][b][m][n] = (f32x4){0.f, 0.f, 0.f, 0.f};
        cur = nxt; cA = nA; cB = nB; ++ui;
        if (align_epi) { if (wr == 1) PG8_BAR; }
    }
    PG8_WAIT_V(0);
    if (!align_epi) { if (wr == 0) PG8_BAR; }
    PG8_BAR;
    if (Ep.MODE == 3) Ep.softmax_store(acc, cur, wr, wc, fr, fq, lds);
#undef PG8_SA
#undef PG8_SB
#undef PG8_STAGE
#undef PG8_LDA
#undef PG8_LDB
#undef PG8_MMA
#undef PG8_WAIT_V
#undef PG8_WAIT_L
#undef PG8_BAR
#undef PG8_SCHED
}
}

DI void transpose_item(const float* W, int K, int N, bf16_t* WT, LAS float* scr, int item, int lane, const float* gk = nullptr) {
    const int nblk = N / 32, kb = item / nblk, nb = item % nblk, k0 = 64 * kb, n0 = 32 * nb;
#pragma unroll 8
    for (int i = 0; i < 32; ++i) { const int kk = 2 * i + (lane >> 5); scr[kk * 33 + (lane & 31)] = __builtin_nontemporal_load(W + (size_t)(k0 + kk) * N + n0 + (lane & 31)) * (gk ? gk[k0 + kk] : 1.f); }
    asm volatile("s_waitcnt lgkmcnt(0)" ::: "memory");
    const int c = lane & 7;
#pragma unroll
    for (int j = 0; j < 4; ++j) { const int n = (lane >> 3) + 8 * j; const LAS float* s = scr + (8 * c) * 33 + n;
        u32x4 o; o.x = pk2(s[0 * 33], s[1 * 33]); o.y = pk2(s[2 * 33], s[3 * 33]); o.z = pk2(s[4 * 33], s[5 * 33]); o.w = pk2(s[6 * 33], s[7 * 33]);
        *(u32x4*)(WT + (size_t)(n0 + n) * K + k0 + 8 * c) = o; }
    asm volatile("s_waitcnt lgkmcnt(0)" ::: "memory");
}
DI void rms_row_bf16(const float* xrow, const float* g, bf16_t* orow, int lane) {
    const f32x4* xr = (const f32x4*)xrow + lane; const f32x4* gr = (const f32x4*)g + lane;
    f32x4 v[8]; float s = 0.f;
#pragma unroll
    for (int j = 0; j < 8; ++j) { v[j] = __builtin_nontemporal_load(xr + 64 * j); s += (v[j].x * v[j].x + v[j].y * v[j].y) + (v[j].z * v[j].z + v[j].w * v[j].w); }
    const float r = rsqrtf(wave_sum(s) * (1.f / DM) + EPS);
    u32x2* o8 = (u32x2*)orow + lane;
#pragma unroll
    for (int j = 0; j < 8; ++j) { const f32x4 gg = gr[64 * j]; u32x2 w; w.x = pk2(v[j].x * r * gg.x, v[j].y * r * gg.y); w.y = pk2(v[j].z * r * gg.z, v[j].w * r * gg.w); o8[64 * j] = w; }
}
DI void rms_rows_phase(const float* X, const float* g, bf16_t* O, int nrows) {
    const int tid_ = opq_tid(), lane = tid_ & 63, gw = opq_bid() * 8 + (tid_ >> 6), NGW = gridDim.x * 8;
    for (int m = gw; m < nrows; m += NGW) rms_row_bf16(X + (size_t)m * DM, g, O + (size_t)m * DM, lane);
}

DI void prologue(const Params& P, LAS unsigned char* lds) {
    const int tid_ = opq_tid(), lane = tid_ & 63, wave = tid_ >> 6, gw = opq_bid() * 8 + wave, NGW = gridDim.x * 8;
    LAS float* scr = (LAS float*)(lds + wave * 16384);
    unsigned char* ws = P.ws;
    constexpr int I_INE = 32 * 192, I_SQ = 32 * 64, I_INO = 32 * 256, I_KV = 32 * 128, I_POOL = 4 * 8;
    constexpr int NITEMS = I_INE + I_SQ + I_INO + I_SQ + 2 * I_KV + 2 * I_SQ + 4 * I_POOL;
    for (int it = gw; it < NITEMS; it += NGW) {
        int r = it;
        if (r < I_INE) { transpose_item(P.w_in_e, DM, 6144, (bf16_t*)(ws + WS_WINE), scr, r, lane); continue; } r -= I_INE;
        if (r < I_SQ) { transpose_item(P.w_out_e, DM, DM, (bf16_t*)(ws + WS_WOUTE), scr, r, lane); continue; } r -= I_SQ;
        if (r < I_INO) { transpose_item(P.w_in_o, DM, 8192, (bf16_t*)(ws + WS_WINO), scr, r, lane, P.g_mix + DM); continue; } r -= I_INO;
        if (r < I_SQ) { transpose_item(P.w_out_o, DM, DM, (bf16_t*)(ws + WS_WOUTO), scr, r, lane); continue; } r -= I_SQ;
        if (r < 2 * I_KV) { const int l = r / I_KV; transpose_item(P.wkv + (size_t)l * DM * 4096, DM, 4096, (bf16_t*)(ws + WS_WKV) + (size_t)l * DM * 4096, scr, r % I_KV, lane); continue; } r -= 2 * I_KV;
        if (r < 2 * I_SQ) { const int l = r / I_SQ; transpose_item(P.wo + (size_t)l * DM * DM, DM, DM, (bf16_t*)(ws + WS_WO) + (size_t)l * DM * DM, scr, r % I_SQ, lane); continue; } r -= 2 * I_SQ;
        { const int g = r / I_POOL; transpose_item(P.pool_w + (size_t)g * 65536, 256, 256, (bf16_t*)(ws + WS_POOLT) + (size_t)g * 65536, scr, r % I_POOL, lane); }
    }
    { const f32x4* src = (const f32x4*)P.wq; u32x2* dst = (u32x2*)(ws + WS_WQ);
      for (int i = opq_bid() * NTH + tid_; i < 2 * DM * DM / 4; i += gridDim.x * NTH) { const float gr = P.g_xa[i >> 9]; const f32x4 v = __builtin_nontemporal_load(src + i) * gr; u32x2 w; w.x = pk2(v.x, v.y); w.y = pk2(v.z, v.w); dst[i] = w; } }
    { float* ss = (float*)(ws + WS_SS); for (int i = opq_bid() * NTH + tid_; i < 4 * MT; i += gridDim.x * NTH) ss[i] = 0.f; }
    rms_rows_phase(P.x, P.g_mix, (bf16_t*)(ws + WS_XN), MT);
    for (int m = gw; m < 1024; m += NGW) { const int l = m >> 9, row = m & 511;
        rms_row_bf16(P.mem + (size_t)row * DM, P.g_mem + l * DM, (bf16_t*)(ws + WS_HM) + (size_t)m * DM, lane); }
}

template <int WIN> DI void pool_mix_group(const bf16_t* U, bf16_t* MIX, int g, size_t first, size_t stride) {
    const size_t NTOT = (size_t)MT * 32;
    for (size_t p = first; p < NTOT; p += stride) {
        const int t = (int)(p >> 5), c0 = g * 256 + (int)(p & 31) * 8, pos = t & (SEQ - 1);
        const int n = (pos + 1 < WIN) ? pos + 1 : WIN;
        const bf16_t* src = U + (size_t)t * LDU_E + c0;
        u32x4 v[WIN];
#pragma unroll
        for (int r = 0; r < WIN; ++r) v[r] = *(const u32x4*)(src - (size_t)(r < n ? r : 0) * LDU_E);
        float a[8] = {0.f, 0.f, 0.f, 0.f, 0.f, 0.f, 0.f, 0.f};
#pragma unroll
        for (int r = 0; r < WIN; ++r) { const float m = (r < n) ? 1.f : 0.f;
            a[0] += m * bflo(v[r].x); a[1] += m * bfhi(v[r].x); a[2] += m * bflo(v[r].y); a[3] += m * bfhi(v[r].y); a[4] += m * bflo(v[r].z); a[5] += m * bfhi(v[r].z); a[6] += m * bflo(v[r].w); a[7] += m * bfhi(v[r].w); }
        const float inv = 1.f / (float)n;
        u32x4 w; w.x = pk2(a[0] * inv - bflo(v[0].x), a[1] * inv - bfhi(v[0].x)); w.y = pk2(a[2] * inv - bflo(v[0].y), a[3] * inv - bfhi(v[0].y));
        w.z = pk2(a[4] * inv - bflo(v[0].z), a[5] * inv - bfhi(v[0].z)); w.w = pk2(a[6] * inv - bflo(v[0].w), a[7] * inv - bfhi(v[0].w));
        *(u32x4*)(MIX + (size_t)t * 1024 + c0) = w;
    }
}
DI void pool_mix_phase(const Params& P) {
    const bf16_t* U = (const bf16_t*)(P.ws + WS_U); bf16_t* MIX = (bf16_t*)(P.ws + WS_MIX);
    const size_t first = (size_t)opq_bid() * NTH + opq_tid(), stride = (size_t)gridDim.x * NTH;
    pool_mix_group<2>(U, MIX, 0, first, stride); pool_mix_group<4>(U, MIX, 1, first, stride); pool_mix_group<8>(U, MIX, 2, first, stride); pool_mix_group<16>(U, MIX, 3, first, stride);
}

constexpr int HG_KT = 17408, HG_IT = 27648, HG_P = 37888, HG_ST = 40448, HG_O = 75264, HG_DEC = 92160;
DI void tr_write8(LAS unsigned char* base, int row_stride_b, int col_b, int r0, const u32x4& v) {
    *(LAS bf16_t*)(base + (r0 + 0) * row_stride_b + col_b) = (bf16_t)(v.x & 0xffffu); *(LAS bf16_t*)(base + (r0 + 1) * row_stride_b + col_b) = (bf16_t)(v.x >> 16);
    *(LAS bf16_t*)(base + (r0 + 2) * row_stride_b + col_b) = (bf16_t)(v.y & 0xffffu); *(LAS bf16_t*)(base + (r0 + 3) * row_stride_b + col_b) = (bf16_t)(v.y >> 16);
    *(LAS bf16_t*)(base + (r0 + 4) * row_stride_b + col_b) = (bf16_t)(v.z & 0xffffu); *(LAS bf16_t*)(base + (r0 + 5) * row_stride_b + col_b) = (bf16_t)(v.z >> 16);
    *(LAS bf16_t*)(base + (r0 + 6) * row_stride_b + col_b) = (bf16_t)(v.w & 0xffffu); *(LAS bf16_t*)(base + (r0 + 7) * row_stride_b + col_b) = (bf16_t)(v.w >> 16);
}

DI void hgrn_passA(const Params& P, LAS unsigned char* lds, int u, bool skip_gates) {
    const int tid = opq_tid(), lane = tid & 63, w = tid >> 6, g = lane >> 4, r16 = lane & 15;
    const int b = u >> 8, h = (u >> 5) & 7, sc = u & 31, tok0 = b * SEQ + sc * 256, chunk0 = tok0 >> 5;
    bf16_t* U = (bf16_t*)(P.ws + WS_U); float* DEC = (float*)(P.ws + WS_DEC);
#pragma unroll 1
    for (int r = skip_gates ? 2 : 0; r < 2; ++r) {
        const int task = tid + NTH * r, ch = task >> 7, d = task & 127, cc = h * 128 + d;
        const float lbv = 1.f / (1.f + __expf(P.lb[1024 + cc] - P.lb[cc]));
        bf16_t* pq = U + (size_t)(tok0 + ch * 32) * LDU_E + 2048 + cc; bf16_t* pf = pq + 1024;
        bf16_t qraw[32], fraw[32];
#pragma unroll
        for (int s = 0; s < 32; ++s) { qraw[s] = pq[(size_t)s * LDU_E]; fraw[s] = pf[(size_t)s * LDU_E]; }
        float bc = 0.f;
#pragma unroll
        for (int s = 0; s < 32; ++s) {
            const float qv = bf2f(qraw[s]), fl = bf2f(fraw[s]);
            const float ex = __expf(-fl), sg = __builtin_amdgcn_rcpf(1.f + ex), f = lbv + (1.f - lbv) * sg, kk = (1.f - lbv) * (ex * sg);
            bc += __logf(f);
            pq[(size_t)s * LDU_E] = (bf16_t)(pk2(qv * __expf(bc), 0.f) & 0xffffu); pf[(size_t)s * LDU_E] = (bf16_t)(pk2(kk * __expf(-bc), 0.f) & 0xffffu);
        }
        DEC[(size_t)(chunk0 + ch) * 1024 + cc] = __expf(bc);
    }
    __syncthreads();
    f32x4 acc[8];
#pragma unroll
    for (int dt = 0; dt < 8; ++dt) acc[dt] = (f32x4){0.f, 0.f, 0.f, 0.f};
    const int row = tid & 31, seg = tid >> 5;
    const bf16_t* src = U + (size_t)(tok0 + row) * LDU_E + h * 128 + seg * 8;
    u32x4 rk = *(const u32x4*)(src + 3072), ri = *(const u32x4*)(src + 4096);
    float rdec = (tid < 128) ? DEC[(size_t)chunk0 * 1024 + h * 128 + tid] : 1.f, dtot = 1.f;
    LAS unsigned char* KT = lds; LAS unsigned char* IT = lds + 10240; LAS float* dec = (LAS float*)(lds + 20480);
    for (int ch = 0; ch < 8; ++ch) {
        tr_write8(KT, 80, row * 2, seg * 8, rk); tr_write8(IT, 80, row * 2, seg * 8, ri);
        if (tid < 128) { dec[tid] = rdec; dtot *= rdec; }
        if (ch < 7) { const bf16_t* s2 = src + (size_t)(ch + 1) * 32 * LDU_E; rk = *(const u32x4*)(s2 + 3072); ri = *(const u32x4*)(s2 + 4096);
            if (tid < 128) rdec = DEC[(size_t)(chunk0 + ch + 1) * 1024 + h * 128 + tid]; }
        __syncthreads();
        const bf16x8 bi = *(const LAS bf16x8*)(IT + (16 * w + r16) * 80 + g * 16);
#pragma unroll
        for (int dt = 0; dt < 8; ++dt) {
            const bf16x8 a = *(const LAS bf16x8*)(KT + (16 * dt + r16) * 80 + g * 16);
            acc[dt] = mfma16(a, bi, acc[dt]);
            const f32x4 dv = *(const LAS f32x4*)(dec + 16 * dt + 4 * g);
            acc[dt] *= dv;
        }
        __syncthreads();
    }
    float* SE = (float*)(P.ws + WS_SE) + (size_t)u * 16384;
#pragma unroll
    for (int dt = 0; dt < 8; ++dt)
#pragma unroll
        for (int j = 0; j < 4; ++j) SE[(16 * dt + 4 * g + j) * 128 + 16 * w + r16] = acc[dt][j];
    if (tid < 128) ((float*)(P.ws + WS_DT))[u * 128 + tid] = dtot;
}

DI void hgrn_scan_phase(const Params& P) {
    float* SE = (float*)(P.ws + WS_SE); const float* DT = (const float*)(P.ws + WS_DT);
    const int NT = gridDim.x * NTH;
    for (int e = opq_bid() * NTH + opq_tid(); e < 16 * 16384; e += NT) {
        const int bh = e >> 14, idx = e & 16383, d = idx >> 7;
        float S = 0.f;
#pragma unroll 8
        for (int sc = 0; sc < 32; ++sc) { const int u = bh * 32 + sc; const float tmp = SE[(size_t)u * 16384 + idx]; SE[(size_t)u * 16384 + idx] = S; S = DT[u * 128 + d] * S + tmp; }
    }
}

DI void hgrn_passC(const Params& P, LAS unsigned char* lds, int u) {
    const int tid = opq_tid(), lane = tid & 63, w = tid >> 6, g = lane >> 4, r16 = lane & 15;
    const int b = u >> 8, h = (u >> 5) & 7, sc = u & 31, tok0 = b * SEQ + sc * 256, chunk0 = tok0 >> 5;
    const bf16_t* U = (const bf16_t*)(P.ws + WS_U); const float* DEC = (const float*)(P.ws + WS_DEC);
    bf16_t* Y = (bf16_t*)(P.ws + WS_XN);
    LAS unsigned char* Qs = lds; LAS unsigned char* Ks = lds + 8704; LAS unsigned char* KT = lds + HG_KT; LAS unsigned char* IT = lds + HG_IT;
    LAS unsigned char* Ps = lds + HG_P; LAS unsigned char* ST = lds + HG_ST; LAS float* Os = (LAS float*)(lds + HG_O); LAS float* dec = (LAS float*)(lds + HG_DEC);
    f32x4 acc[8];
    { const float* SEb = (const float*)(P.ws + WS_SE); const float* DTb = (const float*)(P.ws + WS_DT);
      f32x4 W[8];
#pragma unroll
      for (int dt = 0; dt < 8; ++dt) { acc[dt] = (f32x4){0.f, 0.f, 0.f, 0.f}; W[dt] = (f32x4){1.f, 1.f, 1.f, 1.f}; }
#pragma unroll 1
      for (int jj = sc - 1; jj >= 0; --jj) {
          const int uj = (u - sc) + jj; const float* SE = SEb + (size_t)uj * 16384; const float* DT = DTb + uj * 128;
          float wmax = 0.f;
#pragma unroll
          for (int dt = 0; dt < 8; ++dt) {
              const f32x4 dv = *(const f32x4*)(DT + 16 * dt + 4 * g);
#pragma unroll
              for (int j = 0; j < 4; ++j) acc[dt][j] += W[dt][j] * SE[(16 * dt + 4 * g + j) * 128 + 16 * w + r16];
              W[dt] *= dv; wmax = fmaxf(wmax, fmaxf(fmaxf(W[dt][0], W[dt][1]), fmaxf(W[dt][2], W[dt][3]))); }
          if (!__any(wmax > 0.f)) break;
      }
#pragma unroll
      for (int dt = 0; dt < 8; ++dt) {
          u32x2 pw; pw.x = pk2(acc[dt][0], acc[dt][1]); pw.y = pk2(acc[dt][2], acc[dt][3]);
          *(LAS u32x2*)(ST + (16 * w + r16) * 272 + (16 * dt + 4 * g) * 2) = pw; } }
    const int row = tid & 31, seg = tid >> 5;
    const bf16_t* src = U + (size_t)(tok0 + row) * LDU_E + h * 128 + seg * 8;
    u32x4 rq = *(const u32x4*)(src + 2048), rk = *(const u32x4*)(src + 3072), ri = *(const u32x4*)(src + 4096);
    float rdec = (tid < 128) ? DEC[(size_t)chunk0 * 1024 + h * 128 + tid] : 1.f;
    const int nc = tid >> 4, nv0 = (tid & 15) * 8;
    f32x4 ng0 = *(const f32x4*)(P.hg + h * 128 + nv0), ng1 = *(const f32x4*)(P.hg + h * 128 + nv0 + 4);
    for (int ch = 0; ch < 8; ++ch) {
        *(LAS u32x4*)(Qs + row * 272 + seg * 16) = rq; *(LAS u32x4*)(Ks + row * 272 + seg * 16) = rk;
        tr_write8(KT, 80, row * 2, seg * 8, rk); tr_write8(IT, 80, row * 2, seg * 8, ri);
        if (tid < 128) dec[tid] = rdec;
        if (ch < 7) { const bf16_t* s2 = src + (size_t)(ch + 1) * 32 * LDU_E; rq = *(const u32x4*)(s2 + 2048); rk = *(const u32x4*)(s2 + 3072); ri = *(const u32x4*)(s2 + 4096);
            if (tid < 128) rdec = DEC[(size_t)(chunk0 + ch + 1) * 1024 + h * 128 + tid]; }
        const u32x4 gv = *(const u32x4*)(U + (size_t)(tok0 + ch * 32 + nc) * LDU_E + 5120 + h * 128 + nv0);
        __syncthreads();
        f32x4 ao[2];
#pragma unroll
        for (int ci = 0; ci < 2; ++ci) { ao[ci] = (f32x4){0.f, 0.f, 0.f, 0.f};
#pragma unroll
            for (int ks = 0; ks < 4; ++ks) { const bf16x8 a = *(const LAS bf16x8*)(Qs + (16 * ci + r16) * 272 + (32 * ks + 8 * g) * 2);
                const bf16x8 bs = *(const LAS bf16x8*)(ST + (16 * w + r16) * 272 + (32 * ks + 8 * g) * 2);
                ao[ci] = mfma16(a, bs, ao[ci]); } }
        if (w < 4) { const int ci = w >> 1, si = w & 1; f32x4 s = (f32x4){0.f, 0.f, 0.f, 0.f};
#pragma unroll
            for (int ks = 0; ks < 4; ++ks) { const bf16x8 a = *(const LAS bf16x8*)(Qs + (16 * ci + r16) * 272 + (32 * ks + 8 * g) * 2);
                const bf16x8 bk = *(const LAS bf16x8*)(Ks + (16 * si + r16) * 272 + (32 * ks + 8 * g) * 2);
                s = mfma16(a, bk, s); }
#pragma unroll
            for (int j = 0; j < 4; ++j) { const int c = 16 * ci + 4 * g + j, sidx = 16 * si + r16;
                *(LAS bf16_t*)(Ps + c * 80 + sidx * 2) = (bf16_t)f2bf(sidx <= c ? s[j] : 0.f); } }
        __syncthreads();
        const bf16x8 bi = *(const LAS bf16x8*)(IT + (16 * w + r16) * 80 + g * 16);
#pragma unroll
        for (int ci = 0; ci < 2; ++ci) { const bf16x8 a = *(const LAS bf16x8*)(Ps + (16 * ci + r16) * 80 + g * 16);
            ao[ci] = mfma16(a, bi, ao[ci]);
#pragma unroll
            for (int j = 0; j < 4; ++j) Os[(16 * ci + 4 * g + j) * 132 + 16 * w + r16] = ao[ci][j]; }
#pragma unroll
        for (int dt = 0; dt < 8; ++dt) {
            const bf16x8 a = *(const LAS bf16x8*)(KT + (16 * dt + r16) * 80 + g * 16);
            acc[dt] = mfma16(a, bi, acc[dt]);
            const f32x4 dv = *(const LAS f32x4*)(dec + 16 * dt + 4 * g);
            acc[dt] *= dv;
            u32x2 pw; pw.x = pk2(acc[dt][0], acc[dt][1]); pw.y = pk2(acc[dt][2], acc[dt][3]);
            *(LAS u32x2*)(ST + (16 * w + r16) * 272 + (16 * dt + 4 * g) * 2) = pw;
        }
        __syncthreads();
        { const f32x4 o0 = *(const LAS f32x4*)(Os + nc * 132 + nv0), o1 = *(const LAS f32x4*)(Os + nc * 132 + nv0 + 4);
          float ss = (o0.x * o0.x + o0.y * o0.y) + (o0.z * o0.z + o0.w * o0.w) + (o1.x * o1.x + o1.y * o1.y) + (o1.z * o1.z + o1.w * o1.w);
          ss += __shfl_xor(ss, 1); ss += __shfl_xor(ss, 2); ss += __shfl_xor(ss, 4); ss += __shfl_xor(ss, 8);
          const float r = rsqrtf(ss * (1.f / 128.f) + EPS);
          u32x4 wv;
          wv.x = pk2(o0.x * r * ng0.x * silu(bflo(gv.x)), o0.y * r * ng0.y * silu(bfhi(gv.x)));
          wv.y = pk2(o0.z * r * ng0.z * silu(bflo(gv.y)), o0.w * r * ng0.w * silu(bfhi(gv.y)));
          wv.z = pk2(o1.x * r * ng1.x * silu(bflo(gv.z)), o1.y * r * ng1.y * silu(bfhi(gv.z)));
          wv.w = pk2(o1.z * r * ng1.z * silu(bflo(gv.w)), o1.w * r * ng1.w * silu(bfhi(gv.w)));
          *(u32x4*)(Y + (size_t)(tok0 + ch * 32 + nc) * DM + 1024 + h * 128 + nv0) = wv; }
    }
    __syncthreads();
}

constexpr size_t WS_VTS0 = 1 * MiB, WS_VTS1 = 470 * MiB;
constexpr int SB_VOFF = 52224, SB_FLAGS = 103424;
constexpr float SB_RDONE = 150.0403f;
template <bool MASK>
DI void sb_block(const LAS unsigned char* kb, const LAS unsigned char* vb, int koff, int s0, int tq, const bf16x8 (&qb)[4], f32x4 (&o)[8], float& R, int g, int r16) {
    const float scl2 = 0.12751743082459868f;
    f32x4 z[2];
#pragma unroll
    for (int kt = 0; kt < 2; ++kt) { z[kt] = (f32x4){0.f, 0.f, 0.f, 0.f};
#pragma unroll
        for (int ks = 0; ks < 4; ++ks) { const bf16x8 a = *(const LAS bf16x8*)(kb + (koff + 16 * kt + r16) * 272 + (32 * ks + 8 * g) * 2); z[kt] = mfma16(a, qb[ks], z[kt]); } }
    float suf[2][4], TT[2];
#pragma unroll
    for (int kt = 0; kt < 2; ++kt) {
        float sp[4];
#pragma unroll
        for (int j = 0; j < 4; ++j) { const float zz = z[kt][j] * scl2; z[kt][j] = zz;
            const float v = fmaxf(zz, 0.f) + __builtin_amdgcn_logf(1.f + __builtin_amdgcn_exp2f(-fabsf(zz)));
            sp[j] = (!MASK || (s0 + 16 * kt + 4 * g + j < tq)) ? v : 0.f; }
        const float s3 = sp[3], s2 = sp[2] + s3, s1 = sp[1] + s2, s0_ = sp[0] + s1;
        const float o16 = __shfl_xor(s0_, 16), a2 = s0_ + o16, b2 = __shfl_xor(a2, 32);
        const float E = ((g & 1) == 0 ? o16 : 0.f) + (g < 2 ? b2 : 0.f);
        TT[kt] = a2 + b2; suf[kt][0] = s0_ + E; suf[kt][1] = s1 + E; suf[kt][2] = s2 + E; suf[kt][3] = s3 + E;
    }
    float base = R; float aw[2][4];
#pragma unroll
    for (int kt = 1; kt >= 0; --kt) {
#pragma unroll
        for (int j = 0; j < 4; ++j) { const float v = __builtin_amdgcn_exp2f(z[kt][j] - (base + suf[kt][j])); aw[kt][j] = (!MASK || (s0 + 16 * kt + 4 * g + j < tq)) ? v : 0.f; }
        base += TT[kt]; }
    R = base;
    u32x4 t; t.x = pk2(aw[0][0], aw[0][1]); t.y = pk2(aw[0][2], aw[0][3]); t.z = pk2(aw[1][0], aw[1][1]); t.w = pk2(aw[1][2], aw[1][3]); const bf16x8 bop = __builtin_bit_cast(bf16x8, t);
#pragma unroll
    for (int vt = 0; vt < 8; ++vt) { const LAS unsigned char* ap = vb + (16 * vt + r16) * 400 + (koff + 4 * g) * 2;
        const bf16x8 a = cat4(*(const LAS s16x4*)ap, *(const LAS s16x4*)(ap + 32)); o[vt] = mfma16(a, bop, o[vt]); }
}
DI void sb_phase(const Params& P, LAS unsigned char* lds) {
    const int tid = opq_tid(), lane = tid & 63, w = tid >> 6, g = lane >> 4, r16 = lane & 15;
    const int bid = opq_bid(), G = gridDim.x;
    const bf16_t* Uall = (const bf16_t*)(P.ws + WS_U); bf16_t* Yall = (bf16_t*)(P.ws + WS_XN);
    LAS int* flags = (LAS int*)(lds + SB_FLAGS);
    u32x4 rk[6], rv[6]; bf16x8 qn[4];
#define SB_LOAD(uu, rr) do { const int qt_ = (uu) & 63, bh_ = (uu) >> 6, b_ = bh_ >> 4, h_ = bh_ & 15, ks_ = qt_ * 128 + 128 - 192 * ((rr) + 1); \
        const bf16_t* Ub_ = Uall + (size_t)b_ * SEQ * LDU_O + 2048 + h_ * 128; const bf16_t* Vb_ = (const bf16_t*)(P.ws + (b_ ? WS_VTS1 : WS_VTS0)) + (size_t)h_ * 128 * SEQ; \
        _Pragma("unroll") for (int i = 0; i < 6; ++i) { const int p = tid + NTH * i; int kg = ks_ + (p >> 4); kg = kg < 0 ? 0 : kg; rk[i] = *(const u32x4*)(Ub_ + (size_t)kg * LDU_O + (p & 15) * 8); \
            const int v_ = p / 24, sg_ = p - 24 * v_; int kc = ks_ + sg_ * 8; kc = kc < 0 ? 0 : kc; rv[i] = *(const u32x4*)(Vb_ + (size_t)v_ * SEQ + kc); } } while (0)
#define SB_LOADQ(uu) do { const int qt_ = (uu) & 63, bh_ = (uu) >> 6, b_ = bh_ >> 4, h_ = bh_ & 15; const bf16_t* qp_ = Uall + ((size_t)b_ * SEQ + qt_ * 128 + 16 * w + r16) * LDU_O + h_ * 128 + 8 * g; \
        _Pragma("unroll") for (int ks = 0; ks < 4; ++ks) qn[ks] = *(const bf16x8*)(qp_ + 32 * ks); } while (0)
    int u = bid, r = 0;
    if (u >= 2048) return;
    SB_LOAD(u, 0); SB_LOADQ(u);
    bf16x8 qb[4]; f32x4 o[8]; float R = 0.f;
#pragma unroll
    for (int ks = 0; ks < 4; ++ks) qb[ks] = qn[ks];
#pragma unroll
    for (int vt = 0; vt < 8; ++vt) o[vt] = (f32x4){0.f, 0.f, 0.f, 0.f};
    for (;;) {
        const int qt = u & 63, bh = u >> 6, b = bh >> 4, h = bh & 15, t0 = qt * 128, tq = t0 + 16 * w + r16, twmax = t0 + 16 * w + 15;
        const int kstart = t0 + 128 - 192 * (r + 1);
#pragma unroll
        for (int i = 0; i < 6; ++i) { const int p = tid + NTH * i; *(LAS u32x4*)(lds + (p >> 4) * 272 + (p & 15) * 16) = rk[i];
            const int v_ = p / 24, sg_ = p - 24 * v_; *(LAS u32x4*)(lds + SB_VOFF + v_ * 400 + sg_ * 16) = rv[i]; }
        const bool spec_same = (r == 0) && (kstart > 0);
        const int nu = spec_same ? u : u + G, nr = spec_same ? 1 : 0;
        if (nu < 2048) { SB_LOAD(nu, nr); if (!spec_same) SB_LOADQ(nu); }
        __syncthreads();
#pragma unroll 1
        for (int hb = 5; hb >= 0; --hb) { const int s0 = kstart + 32 * hb;
            if (s0 < 0) break;
            if (s0 >= twmax) continue;
            if (__all(R > SB_RDONE)) break;
            if (s0 + 32 > twmax - 15) sb_block<true>(lds, lds + SB_VOFF, 32 * hb, s0, tq, qb, o, R, g, r16);
            else sb_block<false>(lds, lds + SB_VOFF, 32 * hb, s0, tq, qb, o, R, g, r16); }
        if (lane == 0) flags[w] = __all(R > SB_RDONE) ? 1 : 0;
        __syncthreads();
        if (spec_same) { r = 1; continue; }
        int alld = 1;
#pragma unroll
        for (int i = 0; i < 8; ++i) alld &= flags[i];
        if (alld || kstart <= 0) {
            { const bf16_t* gp = Uall + ((size_t)b * SEQ + tq) * LDU_O + 6144 + h * 128 + 4 * g; bf16_t* yp = (bf16_t*)Uall + ((size_t)b * SEQ + tq) * LDU_O + h * 128 + 4 * g;
#pragma unroll
              for (int vt = 0; vt < 8; ++vt) { const u32x2 gv = *(const u32x2*)(gp + 16 * vt);
                  u32x2 wv; wv.x = pk2(o[vt][0] * silu(bflo(gv.x)), o[vt][1] * silu(bfhi(gv.x))); wv.y = pk2(o[vt][2] * silu(bflo(gv.y)), o[vt][3] * silu(bfhi(gv.y)));
                  *(u32x2*)(yp + 16 * vt) = wv; } }
            u = nu; r = 0; R = 0.f;
            if (u >= 2048) break;
#pragma unroll
            for (int ks = 0; ks < 4; ++ks) qb[ks] = qn[ks];
#pragma unroll
            for (int vt = 0; vt < 8; ++vt) o[vt] = (f32x4){0.f, 0.f, 0.f, 0.f};
        } else {
            r = r + 1; SB_LOAD(u, r);
        }
    }
#undef SB_LOAD
#undef SB_LOADQ
    __syncthreads();
}

DI void final_norm_phase(const Params& P) {
    const int tid_ = opq_tid(), lane = tid_ & 63, gw = opq_bid() * 8 + (tid_ >> 6), NGW = gridDim.x * 8;
    const bf16_t* X = (const bf16_t*)(P.ws + WS_XN); const float* SS = (const float*)(P.ws + WS_SS) + 3 * MT;
    for (int mrow = gw; mrow < MT; mrow += NGW) {
        const u32x4* xr = (const u32x4*)(X + (size_t)mrow * DM) + lane; f32x4* orow = (f32x4*)(P.out + (size_t)mrow * DM); const f32x4* gr = (const f32x4*)P.g_fin;
        const float r = rsqrtf(SS[mrow] * (1.f / DM) + EPS);
        u32x4 v[4];
#pragma unroll
        for (int j = 0; j < 4; ++j) v[j] = __builtin_nontemporal_load(xr + 64 * j);
#pragma unroll
        for (int j = 0; j < 4; ++j) { const int c4 = (64 * j + lane) * 2; const f32x4 g0 = gr[c4], g1 = gr[c4 + 1];
            __builtin_nontemporal_store((f32x4){bflo(v[j].x) * r * g0.x, bfhi(v[j].x) * r * g0.y, bflo(v[j].y) * r * g0.z, bfhi(v[j].y) * r * g0.w}, orow + c4);
            __builtin_nontemporal_store((f32x4){bflo(v[j].z) * r * g1.x, bfhi(v[j].z) * r * g1.y, bflo(v[j].w) * r * g1.z, bfhi(v[j].w) * r * g1.w}, orow + c4 + 1); }
    }
}

#define XB_TMO      128
#define XB_XCNT(j)  (256  + 64 * (j))
#define XB_XSUB(j)  (1280 + 64 * (j))
#define XB_XGEN(j)  (2304 + 64 * (j))
#define XB_TOP      3328
#define XB_TOPGEN   3392
#define XCD_BAR_WORDS 3456
#define XB_SPIN_CAP (1u << 18)
DI unsigned xb_ld(unsigned* p)              { return __hip_atomic_load(p, __ATOMIC_RELAXED, __HIP_MEMORY_SCOPE_AGENT); }
DI unsigned xb_add(unsigned* p, unsigned v) { return __hip_atomic_fetch_add(p, v, __ATOMIC_RELAXED, __HIP_MEMORY_SCOPE_AGENT); }
DI unsigned xb_xcc_id() { return (unsigned)__builtin_amdgcn_s_getreg((3 << 11) | 20) & 0xFu; }
#define XB_SPIN(cond, bar) do { unsigned _sp = 0; while (cond) { __builtin_amdgcn_s_sleep(1); \
    if ((++_sp & 255u) == 0u) { if (xb_ld(&(bar)[XB_TMO])) break; if (_sp > XB_SPIN_CAP) { atomicAdd(&(bar)[XB_TMO], 1u); break; } } } } while (0)
struct XcdBarrier { unsigned* bar; unsigned x; volatile LAS unsigned* st; };
DI XcdBarrier xcd_barrier_post(unsigned* bar, volatile LAS unsigned* st) {
    XcdBarrier b; b.bar = bar; b.x = xb_xcc_id(); b.st = st;
    if (threadIdx.x == 0) (void)xb_add(&bar[XB_XCNT(b.x)], 1u);
    return b;
}
DI void xcd_barrier_complete(unsigned* bar, unsigned x, unsigned& nloc, unsigned& nx) {
    const unsigned G = gridDim.x * gridDim.y * gridDim.z;
    unsigned sum, cnt, mine, sp = 0u;
    for (;;) {
        sum = 0u; cnt = 0u; mine = 0u;
#pragma unroll
        for (unsigned j = 0; j < 16; ++j) { const unsigned c = xb_ld(&bar[XB_XCNT(j)]); sum += c; cnt += (c > 0u) ? 1u : 0u; mine = (j == x) ? c : mine; }
        if (sum == G) break;
        __builtin_amdgcn_s_sleep(1);
        if ((++sp & 255u) == 0u) { if (xb_ld(&bar[XB_TMO])) break; if (sp > XB_SPIN_CAP) { atomicAdd(&bar[XB_TMO], 1u); break; } }
    }
    nloc = mine > 0u ? mine : 1u; nx = cnt > 0u ? cnt : 1u;
}
DI void xcd_barrier(const XcdBarrier& b) {
    asm volatile("s_waitcnt vmcnt(0)" ::: "memory");
    __syncthreads();
    if (threadIdx.x == 0) {
        unsigned* bar = b.bar;
        __builtin_amdgcn_s_waitcnt(0);
        unsigned nloc = b.st[0], nx = b.st[1];
        if (nloc == 0u) { xcd_barrier_complete(bar, b.x, nloc, nx); b.st[0] = nloc; b.st[1] = nx; }
        const unsigned old = xb_add(&bar[XB_XSUB(b.x)], 1u);
        const unsigned gen = old / nloc;
        if (old + 1u == (gen + 1u) * nloc) {
            __builtin_amdgcn_fence(__ATOMIC_RELEASE, "agent");
            asm volatile("s_waitcnt vmcnt(0)" ::: "memory");
            const unsigned og = xb_add(&bar[XB_TOP], 1u);
            const unsigned tg = og / nx;
            if (og + 1u == (tg + 1u) * nx) xb_add(&bar[XB_TOPGEN], 1u);
            else XB_SPIN(xb_ld(&bar[XB_TOPGEN]) == tg, bar);
            __builtin_amdgcn_fence(__ATOMIC_ACQUIRE, "agent");
            xb_add(&bar[XB_XGEN(b.x)], 1u);
            asm volatile("s_waitcnt vmcnt(0)" ::: "memory");
        } else {
            XB_SPIN(xb_ld(&bar[XB_XGEN(b.x)]) == gen, bar);
            __builtin_amdgcn_fence(__ATOMIC_ACQUIRE, "agent");
            asm volatile("s_waitcnt vmcnt(0)" ::: "memory");
        }
    }
    __syncthreads();
}

__global__ void __launch_bounds__(NTH, 2) fwd_megakernel(Params P0) {
    extern __shared__ __attribute__((aligned(16))) unsigned char lds_raw[];
    LAS unsigned char* lds = (LAS unsigned char*)lds_raw;
    cg::grid_group grid = cg::this_grid();
    if (threadIdx.x < 4) ((LAS unsigned*)(lds + LDS_BARST))[threadIdx.x] = 0u;
    __syncthreads();
    const XcdBarrier xbar = xcd_barrier_post((unsigned*)P0.ws, (volatile LAS unsigned*)(lds + LDS_BARST));
    const int G = gridDim.x, nph = P0.nph;

    if (nph < 0) grid.sync();
    constexpr unsigned GEMM_MASK = (1u << 1) | (1u << 2) | (1u << 4) | (1u << 5) | (1u << 7) | (1u << 9) | (1u << 11) | (1u << 13) | (1u << 15) | (1u << 17);
#pragma unroll 1
    for (int ph = 0; ph < nph; ++ph) {
        Params P = P0; { unsigned char* w_ = P0.ws; asm volatile("" : "+s"(w_)); P.ws = w_; }
        unsigned char* ws = P.ws; const int bid = opq_bid();
        bf16_t* XN = (bf16_t*)(ws + WS_XN); bf16_t* Ub = (bf16_t*)(ws + WS_U);
        if (ph == 3 || ph == 6 || ph == 8 || ph == 10 || ph == 14 || ph == 16) continue;
        const int nrep = ((PROBE_MASK >> ph) & 1u) ? 2 : 1;
        for (int rep = 0; rep < nrep; ++rep) {
        if (rep) __syncthreads();
        if (ph == 0) prologue(P, lds);
        else if (ph == 2) { pool_mix_phase(P); for (int u = bid; u < 512; u += G) hgrn_passA(P, lds, u, rep > 0); }
        else if (ph == 3) { if (rep == 0) hgrn_scan_phase(P); }
        else if (ph == 4) { for (int u = bid; u < 512; u += G) hgrn_passC(P, lds, u); }
        else if (ph == 12) sb_phase(P, lds);
        else if (ph == 18) final_norm_phase(P);
        if ((GEMM_MASK >> ph) & 1u) {
            pg8::Sched S; pg8::Epi E{};
            const int layer = (ph >= 12) ? 1 : 0;
            bf16_t* XN2 = (bf16_t*)(ws + WS_U + 64 * MiB);
            bf16_t* BtS = (bf16_t*)(ws + (layer ? 89 : 1) * MiB); bf16_t* BtN = (bf16_t*)(ws + (layer ? 97 : 9) * MiB);
            const bf16_t* A = (ph == 9 || ph == 13 || ph == 17) ? Ub : ((ph == 7) ? XN2 : XN); const bf16_t* Bt; int N = DM, K = DM, lda = DM, ldb = DM, apn = 0; long bbs = 0;
            E.MODE = (ph == 5 || ph == 9 || ph == 13 || ph == 17) ? 1 : (ph == 4 ? 2 : ((ph == 7 || ph == 15) ? 3 : 0)); E.PERM = true;
            E.O = Ub; E.ldc = DM; E.KX = (bf16_t*)(ws + WS_KX); E.VX = (bf16_t*)(ws + WS_VT); E.BtS = BtS; E.BtN = BtN; E.BtS1 = (bf16_t*)(ws + 89 * MiB); E.BtN1 = (bf16_t*)(ws + 97 * MiB); E.res = (ph == 5) ? P.x : nullptr; E.resb = (ph == 9) ? XN2 : ((ph == 13 || ph == 17) ? XN : nullptr); E.out = P.out; E.xr_out = (ph == 5) ? XN2 : XN; E.gate = Ub + 1024; E.pscale = P.pool_s;
            { float* SS = (float*)(ws + WS_SS); const int si = (ph == 5 || ph == 7) ? 0 : ((ph == 9 || ph == 11) ? 1 : ((ph == 17) ? 3 : 2));
              const bool prod = (ph == 5 || ph == 9 || ph == 13 || ph == 17), cons = (ph == 7 || ph == 11 || ph == 15);
              E.ss_out = prod ? SS + si * MT : nullptr; E.ss_in = cons ? SS + si * MT : nullptr; }
            E.vt_lo = (ph == 11) ? 16 : (1 << 20); E.VTS0 = (bf16_t*)(ws + WS_VTS0); E.VTS1 = (bf16_t*)(ws + WS_VTS1);
            if (ph == 1) { Bt = (const bf16_t*)(ws + WS_WINE); N = 6144; E.ldc = LDU_E; }
            else if (ph == 2) { Bt = nullptr; K = 512; }
            else if (ph == 4) { A = (const bf16_t*)(ws + WS_MIX); Bt = (const bf16_t*)(ws + WS_POOLT); N = 1024; K = 256; lda = 1024; ldb = 256; apn = 512; E.O = XN; }
            else if (ph == 5) Bt = (const bf16_t*)(ws + WS_WOUTE);
            else if (ph == 7 || ph == 15) { Bt = BtS; N = 1024; bbs = 1024L * DM; E.ldc = 1024; }
            else if (ph == 9 || ph == 17) { Bt = BtN; K = 1024; lda = 1024; ldb = 1024; bbs = 2048L * 1024; }
            else if (ph == 11) { Bt = (const bf16_t*)(ws + WS_WINO); N = 8192; E.ldc = LDU_O; }
            else { Bt = (const bf16_t*)(ws + WS_WOUTO); lda = LDU_O; }
            S.init(A, Bt, MT, N, K, lda, ldb, apn); S.b_batch_stride = bbs;
            if (ph == 1) { S.n_extra = 64; S.A2 = (const bf16_t*)(ws + WS_HM); S.B2 = (const bf16_t*)(ws + WS_WKV); }
            if (ph == 2) { S.pre = 1; S.KXl = (const bf16_t*)(ws + WS_KX); S.VXl = (const bf16_t*)(ws + WS_VT); S.WQp = (const bf16_t*)(ws + WS_WQ); S.WOt = (const bf16_t*)(ws + WS_WO); }
            pg8::gemm_phase(lds, S, E);
        }
        }
        if (ph + 1 < nph) xcd_barrier(xbar);
#ifdef PROBE_SYNCS
        if (ph == 5) { for (int i = 0; i < PROBE_SYNCS; ++i) xcd_barrier(xbar); }
#endif
    }
}

extern "C" void kernel_launch(void* const* d_in, const int* in_sizes, int n_in, void* d_out, int out_size, void* d_ws, size_t ws_size, hipStream_t stream) {
    static int grid = 0;
    if (grid == 0) {
        if (n_in != 17 || out_size != MT * DM || ws_size < WS_END) { fprintf(stderr, "kernel_launch: unexpected shapes (n_in %d out %d ws %zu)\n", n_in, out_size, ws_size); grid = -1; return; }
        int dev = 0, cus = 0, per_cu = 0;
        (void)hipGetDevice(&dev);
        (void)hipDeviceGetAttribute(&cus, hipDeviceAttributeMultiprocessorCount, dev);
        if (hipFuncSetAttribute((const void*)fwd_megakernel, hipFuncAttributeMaxDynamicSharedMemorySize, LDS_BYTES) != hipSuccess) { fprintf(stderr, "kernel_launch: hipFuncSetAttribute failed\n"); grid = -1; return; }
        if (hipOccupancyMaxActiveBlocksPerMultiprocessor(&per_cu, (const void*)fwd_megakernel, NTH, LDS_BYTES) != hipSuccess || per_cu < 1) { fprintf(stderr, "kernel_launch: occupancy query failed (%d)\n", per_cu); per_cu = 1; }
        (void)hipGetLastError();
        grid = cus * per_cu;
        fprintf(stderr, "kernel_launch: grid %d (cus %d x %d)\n", grid, cus, per_cu);
    }
    if (grid < 0) return;
    Params p{};
    const float** pp = (const float**)&p;
    for (int i = 0; i < 17; ++i) pp[i] = (const float*)d_in[i];
    p.out = (float*)d_out; p.ws = (unsigned char*)d_ws; p.nph = 19;
    if (hipMemsetAsync(d_ws, 0, 16384, stream) != hipSuccess) { fprintf(stderr, "kernel_launch: memset failed\n"); return; }
    void* args[] = {&p};
    hipError_t e = hipLaunchCooperativeKernel((const void*)fwd_megakernel, dim3(grid), dim3(NTH), args, LDS_BYTES, stream);
    if (e != hipSuccess) fprintf(stderr, "cooperative launch failed: %s (grid %d)\n", hipGetErrorString(e), grid);
}
```
